# Optimizing an MI355X kernel written in HIP

```python
import jax
import jax.numpy as jnp
from jax import lax
import numpy as np

D_MODEL = 1024
BATCH = 2
SEQ = 16384
DEPTH = 4
DEC_BATCH = 8
DEC_SEQ = 32
PAST_LEN = 1024

CHUNK = 64
N_EVEN = (DEPTH + 1) // 2
N_ODD = DEPTH // 2
D_FF = 2816
FFN_RES = 0.5
A_HEAD_DIM = 64
D_A = D_MODEL // 2
A_HEADS = D_A // A_HEAD_DIM
DECAY_RANK = 64
ICL_RANK = 64
GATE_RANK = 128
A_COLS = 3 * D_A + DECAY_RANK + ICL_RANK + GATE_RANK
D_B = D_MODEL - D_A
CONV_W = 3
B_COLS = 3 * D_B
EVEN_IN = A_COLS + B_COLS
D_EVEN_OUT = D_A + D_B
C_HEADS = 4
C_DK = D_MODEL // 2 // C_HEADS
C_DV = D_MODEL // C_HEADS
C_KEY = C_HEADS * C_DK
C_VAL = C_HEADS * C_DV
GLA_GATE_RANK = 16
GLA_GATE_NORM = 16.0
ODD_IN = 2 * C_KEY + 2 * C_VAL + GLA_GATE_RANK

RMS_EPS = 1e-6
GN_EPS = 64e-5
L2_EPS = 1e-12

kernel_name = 'hybrid_streaming_encoder_step'


def _rms(x, g):
    xf = x.astype(jnp.float32)
    xf = xf * lax.rsqrt(jnp.mean(xf * xf, axis=-1, keepdims=True) + RMS_EPS)
    return (xf * g.astype(jnp.float32)).astype(x.dtype)


def _swiglu(h, w_gate, w_up, w_down):
    a = jnp.einsum('btd,df->btf', h, w_gate)
    b = jnp.einsum('btd,df->btf', h, w_up)
    return jnp.einsum('btf,fd->btd', jax.nn.silu(a) * b, w_down)


def _rwkv7_scan(r, w, k, v, kk, a, s0):
    def step(s, inp):
        r_t, w_t, k_t, v_t, kk_t, a_t = inp
        sa = jnp.einsum('bhvk,bhk->bhv', s, kk_t)
        s = (s * w_t[:, :, None, :]
             - sa[..., None] * (kk_t * a_t)[:, :, None, :]
             + v_t[..., None] * k_t[:, :, None, :])
        y = jnp.einsum('bhvk,bhk->bhv', s, r_t)
        return s, y
    xs = tuple(jnp.moveaxis(z, 1, 0) for z in (r, w, k, v, kk, a))
    s_fin, ys = lax.scan(step, s0, xs)
    return jnp.moveaxis(ys, 0, 1), s_fin


def _gla_chunked(q, k, v, log_a, s0):
    bsz, t, nh, _ = q.shape
    dv = v.shape[-1]
    blk = CHUNK if t % CHUNK == 0 else t
    nc = t // blk

    def blocks(z):
        return z.reshape(bsz, nc, blk, nh, z.shape[-1]).transpose(1, 0, 3, 2, 4)

    qb, kb, vb, gb = blocks(q), blocks(k), blocks(v), blocks(log_a)
    cum = jnp.cumsum(gb, axis=3)
    last = cum[:, :, :, -1:, :]
    q_dec = qb * jnp.exp(cum)
    k_dec = kb * jnp.exp(-cum)
    k_to_end = kb * jnp.exp(last - cum)
    mask = jnp.tril(jnp.ones((blk, blk), dtype=bool))
    scores = jnp.where(mask, jnp.einsum('nbhtd,nbhsd->nbhts', q_dec, k_dec), 0.0)
    o_intra = jnp.einsum('nbhts,nbhsv->nbhtv', scores, vb)
    kv_blk = jnp.einsum('nbhsd,nbhsv->nbhdv', k_to_end, vb)
    blk_decay = jnp.exp(last[:, :, :, 0, :])

    def step(s, inp):
        q_c, kv_c, dec_c = inp
        o_inter = jnp.einsum('bhtd,bhdv->bhtv', q_c, s)
        s = s * dec_c[..., None] + kv_c
        return s, o_inter

    s_fin, o_inter = lax.scan(step, s0, (q_dec, kv_blk, blk_decay))
    o = (o_intra + o_inter).transpose(1, 0, 3, 2, 4).reshape(bsz, t, nh, dv)
    return o, s_fin


def _even_mixer(h, shift_buf, wkv0, conv_buf, p, i):
    bsz, t, _ = h.shape
    f32 = jnp.float32
    proj = jnp.einsum('btd,de->bte', h, p['ev_w_in'][i]).astype(f32)
    pa, pb = proj[..., :A_COLS], proj[..., A_COLS:]
    prev = jnp.concatenate([shift_buf.astype(f32)[:, None], pa[:, :-1]], axis=1)
    xs = pa + (prev - pa) * p['rwkv_mu'][i]
    r = xs[..., :D_A]
    k = xs[..., D_A:2 * D_A]
    v = xs[..., 2 * D_A:3 * D_A]
    o = 3 * D_A
    w_lo = xs[..., o:o + DECAY_RANK]
    o += DECAY_RANK
    a_lo = xs[..., o:o + ICL_RANK]
    o += ICL_RANK
    g_lo = xs[..., o:o + GATE_RANK]
    w_log = jax.nn.log_sigmoid(p['rwkv_w0'][i] + jnp.tanh(w_lo) @ p['rwkv_w_up'][i]) - 0.5
    decay = jnp.exp(-jnp.exp(w_log))
    a = jax.nn.sigmoid(p['rwkv_a0'][i] + a_lo @ p['rwkv_a_up'][i])
    g = jax.nn.sigmoid(g_lo) @ p['rwkv_g_up'][i]

    def heads(z):
        return z.reshape(bsz, t, A_HEADS, A_HEAD_DIM)

    kk = heads(k * p['rwkv_k_k'][i])
    kk = kk / jnp.maximum(jnp.sqrt(jnp.sum(kk * kk, axis=-1, keepdims=True)), L2_EPS)
    k_eff = heads(k * (1.0 + (a - 1.0) * p['rwkv_k_a'][i]))
    r_h, v_h = heads(r), heads(v)
    y, wkv_fin = _rwkv7_scan(r_h, heads(decay), k_eff, v_h, kk, heads(a), wkv0.astype(f32))
    mean = jnp.mean(y, axis=-1, keepdims=True)
    var = jnp.mean(jnp.square(y - mean), axis=-1, keepdims=True)
    y = ((y - mean) * lax.rsqrt(var + GN_EPS)).reshape(bsz, t, D_A) * p['rwkv_ln_w'][i] + p['rwkv_ln_b'][i]
    bonus = jnp.sum(r_h * k_eff * p['rwkv_r_k'][i], axis=-1, keepdims=True) * v_h
    y_a = (y + bonus.reshape(bsz, t, D_A)) * g
    gate_b, gate_c, hb = pb[..., :D_B], pb[..., D_B:2 * D_B], pb[..., 2 * D_B:]
    u = gate_c * hb
    padded = jnp.concatenate([conv_buf.astype(f32), u], axis=1)
    conv = lax.conv_general_dilated(padded, p['conv_w'][i].astype(f32)[:, None, :],
                                    window_strides=(1,), padding='VALID',
                                    dimension_numbers=('NWC', 'WIO', 'NWC'),
                                    feature_group_count=D_B)
    y_b = gate_b * conv
    out = jnp.einsum('bte,ed->btd', jnp.concatenate([y_a, y_b], axis=-1).astype(h.dtype), p['ev_w_out'][i])
    return out, pa[:, -1], wkv_fin, padded[:, -(CONV_W - 1):]


def _odd_mixer(h, gla0, p, i):
    bsz, t, _ = h.shape
    f32 = jnp.float32
    proj = jnp.einsum('btd,de->bte', h, p['od_w_in'][i]).astype(f32)
    q = proj[..., :C_KEY]
    k = proj[..., C_KEY:2 * C_KEY]
    v = proj[..., 2 * C_KEY:2 * C_KEY + C_VAL]
    g = proj[..., 2 * C_KEY + C_VAL:2 * C_KEY + 2 * C_VAL]
    a_lo = proj[..., 2 * C_KEY + 2 * C_VAL:]
    log_a = jax.nn.log_sigmoid(a_lo @ p['gla_a_up'][i] + p['gla_a_b'][i]) / GLA_GATE_NORM
    q = q.reshape(bsz, t, C_HEADS, C_DK) * (C_DK ** -0.5)
    k = k.reshape(bsz, t, C_HEADS, C_DK)
    v = v.reshape(bsz, t, C_HEADS, C_DV)
    log_a = log_a.reshape(bsz, t, C_HEADS, C_DK)
    o, gla_fin = _gla_chunked(q, k, v, log_a, gla0.astype(f32))
    o = o * lax.rsqrt(jnp.mean(o * o, axis=-1, keepdims=True) + RMS_EPS) * p['gla_norm'][i]
    o = o.reshape(bsz, t, C_VAL) * jax.nn.silu(g)
    out = jnp.einsum('bte,ed->btd', o.astype(h.dtype), p['od_w_out'][i])
    return out, gla_fin


def _trunk(x, shift0, wkv0, conv0, gla0, p):
    new_shift, new_wkv, new_conv, new_gla = [], [], [], []
    for layer in range(DEPTH):
        x = x + FFN_RES * _swiglu(_rms(x, p['ffn_norm'][layer, 0]), p['ffn_w_gate'][layer, 0],
                                  p['ffn_w_up'][layer, 0], p['ffn_w_down'][layer, 0])
        h = _rms(x, p['mix_norm'][layer])
        i = layer // 2
        if layer % 2 == 0:
            out, sh, wkv, cv = _even_mixer(h, shift0[i], wkv0[i], conv0[i], p, i)
            new_shift.append(sh)
            new_wkv.append(wkv)
            new_conv.append(cv)
        else:
            out, sg = _odd_mixer(h, gla0[i], p, i)
            new_gla.append(sg)
        x = x + out
        x = x + FFN_RES * _swiglu(_rms(x, p['ffn_norm'][layer, 1]), p['ffn_w_gate'][layer, 1],
                                  p['ffn_w_up'][layer, 1], p['ffn_w_down'][layer, 1])
    y = _rms(x, p['final_norm'])
    return y, jnp.stack(new_shift), jnp.stack(new_wkv), jnp.stack(new_conv), jnp.stack(new_gla)


def setup_inputs(seed: int = 0) -> dict:
    key = jax.random.key(seed)
    ks = iter(jax.random.split(key, 40))

    def nrm(shape, scale):
        return scale * jax.random.normal(next(ks), shape, jnp.float32)

    return {
        'x_prompt': nrm((BATCH, SEQ, D_MODEL), 1.0),
        'x_sample': nrm((DEC_BATCH, DEC_SEQ, D_MODEL), 1.0),
        'state_rwkv_shift': nrm((N_EVEN, DEC_BATCH, A_COLS), 1.0),
        'state_rwkv_wkv': nrm((N_EVEN, DEC_BATCH, A_HEADS, A_HEAD_DIM, A_HEAD_DIM), 0.3),
        'state_conv': nrm((N_EVEN, DEC_BATCH, CONV_W - 1, D_B), 0.5),
        'state_gla': nrm((N_ODD, DEC_BATCH, C_HEADS, C_DK, C_DV), 0.3),
        'ffn_norm': 1.0 + nrm((DEPTH, 2, D_MODEL), 0.02),
        'ffn_w_gate': nrm((DEPTH, 2, D_MODEL, D_FF), D_MODEL ** -0.5),
        'ffn_w_up': nrm((DEPTH, 2, D_MODEL, D_FF), D_MODEL ** -0.5),
        'ffn_w_down': nrm((DEPTH, 2, D_FF, D_MODEL), D_FF ** -0.5),
        'mix_norm': 1.0 + nrm((DEPTH, D_MODEL), 0.02),
        'ev_w_in': nrm((N_EVEN, D_MODEL, EVEN_IN), D_MODEL ** -0.5),
        'ev_w_out': nrm((N_EVEN, D_EVEN_OUT, D_MODEL), D_EVEN_OUT ** -0.5),
        'rwkv_mu': jax.random.uniform(next(ks), (N_EVEN, A_COLS), jnp.float32),
        'rwkv_w0': nrm((N_EVEN, D_A), 0.5),
        'rwkv_w_up': nrm((N_EVEN, DECAY_RANK, D_A), 0.3 * DECAY_RANK ** -0.5),
        'rwkv_a0': nrm((N_EVEN, D_A), 0.3),
        'rwkv_a_up': nrm((N_EVEN, ICL_RANK, D_A), 0.5 * ICL_RANK ** -0.5),
        'rwkv_g_up': nrm((N_EVEN, GATE_RANK, D_A), GATE_RANK ** -0.5),
        'rwkv_k_k': 0.85 + nrm((N_EVEN, D_A), 0.05),
        'rwkv_k_a': 1.0 + nrm((N_EVEN, D_A), 0.05),
        'rwkv_r_k': nrm((N_EVEN, A_HEADS, A_HEAD_DIM), 0.1),
        'rwkv_ln_w': 1.0 + nrm((N_EVEN, D_A), 0.02),
        'rwkv_ln_b': nrm((N_EVEN, D_A), 0.02),
        'conv_w': nrm((N_EVEN, CONV_W, D_B), CONV_W ** -0.5),
        'od_w_in': nrm((N_ODD, D_MODEL, ODD_IN), D_MODEL ** -0.5),
        'od_w_out': nrm((N_ODD, C_VAL, D_MODEL), C_VAL ** -0.5),
        'gla_a_up': nrm((N_ODD, GLA_GATE_RANK, C_KEY), GLA_GATE_RANK ** -0.5),
        'gla_a_b': nrm((N_ODD, C_KEY), 0.5),
        'gla_norm': 1.0 + nrm((N_ODD, C_DV), 0.02),
        'final_norm': 1.0 + nrm((D_MODEL,), 0.02),
    }


def reference(x_prompt, x_sample, state_rwkv_shift, state_rwkv_wkv, state_conv, state_gla,
              ffn_norm, ffn_w_gate, ffn_w_up, ffn_w_down, mix_norm,
              ev_w_in, ev_w_out, rwkv_mu, rwkv_w0, rwkv_w_up, rwkv_a0, rwkv_a_up, rwkv_g_up,
              rwkv_k_k, rwkv_k_a, rwkv_r_k, rwkv_ln_w, rwkv_ln_b, conv_w,
              od_w_in, od_w_out, gla_a_up, gla_a_b, gla_norm, final_norm):
    p = {
        'ffn_norm': ffn_norm, 'ffn_w_gate': ffn_w_gate, 'ffn_w_up': ffn_w_up, 'ffn_w_down': ffn_w_down,
        'mix_norm': mix_norm, 'ev_w_in': ev_w_in, 'ev_w_out': ev_w_out, 'rwkv_mu': rwkv_mu,
        'rwkv_w0': rwkv_w0, 'rwkv_w_up': rwkv_w_up, 'rwkv_a0': rwkv_a0, 'rwkv_a_up': rwkv_a_up,
        'rwkv_g_up': rwkv_g_up, 'rwkv_k_k': rwkv_k_k, 'rwkv_k_a': rwkv_k_a, 'rwkv_r_k': rwkv_r_k,
        'rwkv_ln_w': rwkv_ln_w, 'rwkv_ln_b': rwkv_ln_b, 'conv_w': conv_w,
        'od_w_in': od_w_in, 'od_w_out': od_w_out, 'gla_a_up': gla_a_up, 'gla_a_b': gla_a_b,
        'gla_norm': gla_norm, 'final_norm': final_norm,
    }
    bsz = x_prompt.shape[0]
    y_prompt, p_shift, p_wkv, p_conv, p_gla = _trunk(
        x_prompt,
        jnp.zeros((N_EVEN, bsz, A_COLS), jnp.float32),
        jnp.zeros((N_EVEN, bsz, A_HEADS, A_HEAD_DIM, A_HEAD_DIM), jnp.float32),
        jnp.zeros((N_EVEN, bsz, CONV_W - 1, D_B), jnp.float32),
        jnp.zeros((N_ODD, bsz, C_HEADS, C_DK, C_DV), jnp.float32),
        p)
    y_sample, s_shift, s_wkv, s_conv, s_gla = _trunk(
        x_sample, state_rwkv_shift, state_rwkv_wkv, state_conv, state_gla, p)
    return (y_prompt, y_sample, p_shift, p_wkv, p_conv, p_gla, s_shift, s_wkv, s_conv, s_gla)
```

```cpp
#include <hip/hip_runtime.h>
#include <hip/hip_cooperative_groups.h>
#include <cstdio>
namespace cg = cooperative_groups;

#ifndef PH_MASK
#define PH_MASK 0xFFFF
#endif
#define PHON(b) ((PH_MASK>>(b))&1)

typedef unsigned short bf16_t;
typedef short bf16x8 __attribute__((ext_vector_type(8)));
typedef float f32x4 __attribute__((ext_vector_type(4)));
typedef float f32x2 __attribute__((ext_vector_type(2)));
typedef unsigned u32x4 __attribute__((ext_vector_type(4)));
typedef unsigned u32x2 __attribute__((ext_vector_type(2)));
#define LAS __attribute__((address_space(3)))

constexpr int MP = 32768, MS = 256, MT = MP + MS;
constexpr int D = 1024, DFF = 2816, NIN = 3328;
constexpr int SEQ = 16384, DSEQ = 32;
constexpr int NPH = 2 + 4 * 13;

constexpr size_t O_Y = 0;
constexpr size_t O_PSHIFT = (size_t)MT * D;
constexpr size_t O_PWKV = O_PSHIFT + 2 * 2 * 1792;
constexpr size_t O_PCONV = O_PWKV + 2 * 2 * 8 * 4096;
constexpr size_t O_PGLA = O_PCONV + 2 * 2 * 2 * 512;
constexpr size_t O_SSHIFT = O_PGLA + (size_t)2 * 2 * 4 * 32768;
constexpr size_t O_SWKV = O_SSHIFT + 2 * 8 * 1792;
constexpr size_t O_SCONV = O_SWKV + (size_t)2 * 8 * 8 * 4096;
constexpr size_t O_SGLA = O_SCONV + 2 * 8 * 2 * 512;
constexpr size_t O_END = O_SGLA + (size_t)2 * 8 * 4 * 32768;

constexpr size_t GU_E = (size_t)5632 * 1024, DN_E = (size_t)1024 * 2816, IN_E = (size_t)3328 * 1024, OUT_E = (size_t)1024 * 1024;
constexpr size_t WL_E = 2 * (GU_E + DN_E) + IN_E + OUT_E;
constexpr size_t WS_WB = 0;
constexpr size_t WS_SMALL = WS_WB + 4 * WL_E * 2;
constexpr size_t SMALL_E = 512 * 64 * 2 + 512 * 128;
constexpr size_t WS_H = WS_SMALL + 2 * SMALL_E * 2;
constexpr size_t WS_BIG = WS_H + (size_t)MT * 1024 * 2;
constexpr size_t WS_HALO = WS_BIG + (size_t)MT * NIN * 2;
constexpr size_t WS_SCAL = WS_HALO + (size_t)(MT / 64) * 2 * NIN * 2;
constexpr size_t WS_DEC = WS_SCAL + (size_t)MT * 8 * 4 * 4;
constexpr size_t WS_PAR = WS_DEC + (size_t)520 * 4 * 128 * 4;
constexpr int NPAR = 19;
constexpr int PIDX[NPAR] = {2, 3, 4, 5, 6, 10, 13, 14, 16, 19, 20, 21, 22, 23, 24, 27, 28, 29, 30};
constexpr size_t PSZ[NPAR] = {28672, 524288, 16384, 2097152, 8192, 4096, 3584, 1024, 1024, 1024, 1024, 1024, 1024, 1024, 3072, 16384, 1024, 512, 1024};
constexpr size_t par_off(int idx) { size_t o = 0; for (int k = 0; k < NPAR; ++k) { if (PIDX[k] == idx) return o; o += PSZ[k]; } return o; }
constexpr size_t WS_GZ = WS_PAR + par_off(-1) * 4;
constexpr size_t WS_GP = WS_GZ + (size_t)2 * 4 * 2 * 15 * 65536;
constexpr size_t WS_BAR = WS_GP + (size_t)2 * 4 * 15 * 128 * 4;
constexpr size_t WS_END = WS_BAR + 16384;
#define PAR(idx) ((const float*)(p.ws + WS_PAR) + par_off(idx))

constexpr int LDS_BYTES = 131072 + 64;

struct Params {
    const float* in[31];
    float* out;
    unsigned char* ws;
    int ph_lo, ph_hi;
};

struct Ctx { unsigned char* ws; float* out; int tid, bid, nb; };

typedef __bf16 bf16x2_t __attribute__((ext_vector_type(2)));
__device__ __forceinline__ unsigned cvt_pk_bf16(float lo, float hi) { f32x2 v = {lo, hi}; bf16x2_t r = __builtin_convertvector(v, bf16x2_t); return __builtin_bit_cast(unsigned, r); }
__device__ __forceinline__ bf16_t f2bf(float x) { return (bf16_t)(cvt_pk_bf16(x, 0.f) & 0xffffu); }
__device__ __forceinline__ float bf2f(bf16_t b) { return __uint_as_float(((unsigned)b) << 16); }
__device__ __forceinline__ float bflo(unsigned u) { return __uint_as_float(u << 16); }
__device__ __forceinline__ float bfhi(unsigned u) { return __uint_as_float(u & 0xffff0000u); }
__device__ __forceinline__ f32x4 unpack4(u32x2 u) { return (f32x4){bflo(u.x), bfhi(u.x), bflo(u.y), bfhi(u.y)}; }
__device__ __forceinline__ u32x2 pack4(f32x4 v) { u32x2 r; r.x = cvt_pk_bf16(v[0], v[1]); r.y = cvt_pk_bf16(v[2], v[3]); return r; }
__device__ __forceinline__ float sigmoidf_(float x) { return __builtin_amdgcn_rcpf(1.0f + __expf(-x)); }
__device__ __forceinline__ float wave_sum(float v) {
#pragma unroll
    for (int o = 32; o > 0; o >>= 1) v += __shfl_xor(v, o);
    return v;
}
template <int CTRL, int RM = 0xf, int BM = 0xf> __device__ __forceinline__ float dppf(float x) { return __int_as_float(__builtin_amdgcn_update_dpp(0, __float_as_int(x), CTRL, RM, BM, true)); }

#define XB_TMO      128
#define XB_XCNT(j)  (256  + 64 * (j))
#define XB_XSUB(j)  (1280 + 64 * (j))
#define XB_XGEN(j)  (2304 + 64 * (j))
#define XB_TOP      3328
#define XB_TOPGEN   3392
#define XCD_BAR_WORDS 3456
#define XB_SPIN_CAP (1u << 18)
__device__ __forceinline__ unsigned xb_ld(unsigned* p)              { return __hip_atomic_load(p, __ATOMIC_RELAXED, __HIP_MEMORY_SCOPE_AGENT); }
__device__ __forceinline__ unsigned xb_add(unsigned* p, unsigned v) { return __hip_atomic_fetch_add(p, v, __ATOMIC_RELAXED, __HIP_MEMORY_SCOPE_AGENT); }
__device__ __forceinline__ unsigned xb_xcc_id() { return (unsigned)__builtin_amdgcn_s_getreg((3 << 11) | 20) & 0xFu; }
#define XB_SPIN(cond, bar) do { unsigned _sp = 0; while (cond) { __builtin_amdgcn_s_sleep(1); \
    if ((++_sp & 255u) == 0u) { if (xb_ld(&(bar)[XB_TMO])) break; if (_sp > XB_SPIN_CAP) { atomicAdd(&(bar)[XB_TMO], 1u); break; } } } } while (0)
struct XcdBarrier { unsigned* bar; unsigned x; volatile LAS unsigned* st; };
__device__ __forceinline__ XcdBarrier xcd_barrier_post(unsigned* bar, volatile LAS unsigned* st) {
    XcdBarrier b; b.bar = bar; b.x = xb_xcc_id(); b.st = st;
    if (threadIdx.x == 0) (void)xb_add(&bar[XB_XCNT(b.x)], 1u);
    return b;
}
__device__ __forceinline__ void xcd_barrier_complete(unsigned* bar, unsigned x, unsigned& nloc, unsigned& nx) {
    const unsigned G = gridDim.x * gridDim.y * gridDim.z;
    unsigned sum, cnt, mine, sp = 0u;
    for (;;) {
        sum = 0u; cnt = 0u; mine = 0u;
#pragma unroll
        for (unsigned j = 0; j < 16; ++j) { const unsigned c = xb_ld(&bar[XB_XCNT(j)]); sum += c; cnt += (c > 0u) ? 1u : 0u; mine = (j == x) ? c : mine; }
        if (sum == G) break;
        __builtin_amdgcn_s_sleep(1);
        if ((++sp & 255u) == 0u) { if (xb_ld(&bar[XB_TMO])) break; if (sp > XB_SPIN_CAP) { atomicAdd(&bar[XB_TMO], 1u); break; } }
    }
    nloc = mine > 0u ? mine : 1u; nx = cnt > 0u ? cnt : 1u;
}
__device__ __forceinline__ void xcd_barrier(const XcdBarrier& b) {
    asm volatile("s_waitcnt vmcnt(0)" ::: "memory");
    __syncthreads();
    if (threadIdx.x == 0) {
        unsigned* bar = b.bar;
        __builtin_amdgcn_s_waitcnt(0);
        unsigned nloc = b.st[0], nx = b.st[1];
        if (nloc == 0u) { xcd_barrier_complete(bar, b.x, nloc, nx); b.st[0] = nloc; b.st[1] = nx; }
        const unsigned old = xb_add(&bar[XB_XSUB(b.x)], 1u);
        const unsigned gen = old / nloc;
        if (old + 1u == (gen + 1u) * nloc) {
            __builtin_amdgcn_fence(__ATOMIC_RELEASE, "agent");
            asm volatile("s_waitcnt vmcnt(0)" ::: "memory");
            const unsigned og = xb_add(&bar[XB_TOP], 1u);
            const unsigned tg = og / nx;
            if (og + 1u == (tg + 1u) * nx) xb_add(&bar[XB_TOPGEN], 1u);
            else XB_SPIN(xb_ld(&bar[XB_TOPGEN]) == tg, bar);
            __builtin_amdgcn_fence(__ATOMIC_ACQUIRE, "agent");
            xb_add(&bar[XB_XGEN(b.x)], 1u);
            asm volatile("s_waitcnt vmcnt(0)" ::: "memory");
        } else {
            XB_SPIN(xb_ld(&bar[XB_XGEN(b.x)]) == gen, bar);
            __builtin_amdgcn_fence(__ATOMIC_ACQUIRE, "agent");
            asm volatile("s_waitcnt vmcnt(0)" ::: "memory");
        }
    }
    __syncthreads();
}

namespace pg8 {
constexpr int BM = 256, BK = 64, HALF = 128, HTB = HALF * BK * 2, STAGE_BYTES = 8 * HTB, NXCD = 8, WGM = 8;
__device__ __forceinline__ int lds_byte(int r, int c) { const int st = (r >> 4) * 2 + (c >> 5), rr = r & 15, cc = c & 31, ob = rr * 64 + cc * 2; return st * 1024 + (ob ^ (((ob >> 9) & 1) << 5)); }
__device__ __forceinline__ void stage_rc(int b, int& R, int& C) { const int st = b / 1024, sb = b % 1024, swz = sb ^ (((sb >> 9) & 1) << 5); R = (st >> 1) * 16 + swz / 64; C = (st & 1) * 32 + (swz % 64) / 2; }
__device__ __forceinline__ int perm32(int rho) { const int n = rho >> 4, i = rho & 15; return 8 * (i >> 2) + 4 * n + (i & 3); }
struct Unit { int pm, pn; };
struct Gemm { const bf16_t* A; const bf16_t* Bt; int M, N, K; };
struct StaticOrder {
    int nM, nN, nwg, G, c;
    __device__ void init(int M, int N, int G_, int c_) { nM = M / BM; nN = N / BM; nwg = nM * nN; G = G_; c = c_; }
    __device__ bool next(int i, Unit& u) const {
        const long L = (long)i * G + c; if (L >= nwg) return false;
        int wgid = (int)L; { const int q = nwg / NXCD, r = nwg % NXCD, xcd = wgid % NXCD, off = wgid / NXCD; wgid = (xcd < r ? xcd * (q + 1) : r * (q + 1) + (xcd - r) * q) + off; }
        const int nig = WGM * nN, gid = wgid / nig, fm = gid * WGM, gsz = (nM - fm) < WGM ? (nM - fm) : WGM;
        u.pm = fm + ((wgid % nig) % gsz); u.pn = (wgid % nig) / gsz; return true;
    }
};

template <class Epi>
__device__ __forceinline__ void gemm_phase(LAS unsigned char* lds, const Gemm g, const StaticOrder& S, const Epi& E, const int tid) {
    const int wid = __builtin_amdgcn_readfirstlane(tid >> 6), lane = tid & 63, wr = wid >> 2, wc = wid & 3, fr = lane & 15, fq = lane >> 4;
    const int K = g.K, nt = K / BK;
    unsigned voffA[2], voffB[2];
#pragma unroll
    for (int i = 0; i < 2; ++i) { int R, C; stage_rc(tid * 16 + i * 8192, R, C); const int Rb = Epi::PERM ? ((R & ~31) + perm32(R & 31)) : R;
        voffA[i] = (unsigned)(R * K + C) * 2u; voffB[i] = (unsigned)(Rb * K + C) * 2u; }
    const size_t kstep = (size_t)(BK * 2);
    const size_t hstep = (size_t)HALF * K * 2;
    const size_t tstep = 2 * hstep;
    const unsigned ldsw = (unsigned)wid * 1024u;
    const int aoff = lds_byte(wr * 64 + fr, fq * 8), boff = lds_byte(wc * 32 + fr, fq * 8);
#define PG8_SA(b, h) (((b) * 2 + (h)) * HTB)
#define PG8_SB(b, h) ((4 + (b) * 2 + (h)) * HTB)
#define PG8_STAGE(bufoff, gbase, voff) do { _Pragma("unroll") for (int _i = 0; _i < 2; ++_i) \
        __builtin_amdgcn_global_load_lds((const unsigned*)((const char*)(gbase) + (voff)[_i]), (LAS unsigned*)(lds + (bufoff) + ldsw + _i * 8192), 16, 0, 0); } while (0)
#define PG8_LDA(dst, b, h) do { _Pragma("unroll") for (int m = 0; m < 4; ++m) _Pragma("unroll") for (int k = 0; k < 2; ++k) dst[m][k] = *(const LAS bf16x8*)(lds + PG8_SA(b, h) + aoff + m * 2048 + k * 1024); } while (0)
#define PG8_LDB(dst, b, h) do { _Pragma("unroll") for (int n = 0; n < 2; ++n) _Pragma("unroll") for (int k = 0; k < 2; ++k) dst[n][k] = *(const LAS bf16x8*)(lds + PG8_SB(b, h) + boff + n * 2048 + k * 1024); } while (0)
#define PG8_MMA(ai, bj, At, Bt) do { __builtin_amdgcn_s_setprio(1); _Pragma("unroll") for (int m = 0; m < 4; ++m) _Pragma("unroll") for (int n = 0; n < 2; ++n) _Pragma("unroll") for (int k = 0; k < 2; ++k) \
        acc[ai][bj][m][n] = __builtin_amdgcn_mfma_f32_16x16x32_bf16(Bt[n][k], At[m][k], acc[ai][bj][m][n], 0, 0, 0); __builtin_amdgcn_s_setprio(0); } while (0)
#define PG8_WAIT_V(n) asm volatile("s_waitcnt vmcnt(" #n ")" ::: "memory")
#define PG8_WAIT_L(n) asm volatile("s_waitcnt lgkmcnt(" #n ")" ::: "memory")
#define PG8_BAR __builtin_amdgcn_s_barrier()
#define PG8_SCHED __builtin_amdgcn_sched_barrier(0)
    Unit cur, nxt; int ui = 0;
    if (!S.next(0, cur)) return;
    f32x4 acc[2][2][4][2];
#pragma unroll
    for (int a = 0; a < 2; ++a)
#pragma unroll
        for (int b = 0; b < 2; ++b)
#pragma unroll
            for (int m = 0; m < 4; ++m)
#pragma unroll
                for (int n = 0; n < 2; ++n) acc[a][b][m][n] = (f32x4){0.f, 0.f, 0.f, 0.f};
    bf16x8 At[4][2], B0[2][2], B1[2][2];
    const char* cA = (const char*)g.A + (size_t)cur.pm * tstep; const char* cB = (const char*)g.Bt + (size_t)cur.pn * tstep;
    PG8_STAGE(PG8_SB(0, 0), cB, voffB); PG8_STAGE(PG8_SA(0, 0), cA, voffA); PG8_STAGE(PG8_SB(0, 1), cB + hstep, voffB); PG8_STAGE(PG8_SA(0, 1), cA + hstep, voffA);
    if (wr == 1) PG8_BAR;
    PG8_WAIT_V(4); PG8_BAR;
    PG8_STAGE(PG8_SB(1, 0), cB + kstep, voffB); PG8_STAGE(PG8_SA(1, 0), cA + kstep, voffA); PG8_STAGE(PG8_SB(1, 1), cB + hstep + kstep, voffB);
    PG8_WAIT_V(6); PG8_BAR;
    for (;;) {
        const bool has_next = S.next(ui + 1, nxt);
        const char* nA = has_next ? (const char*)g.A + (size_t)nxt.pm * tstep : cA; const char* nB = has_next ? (const char*)g.Bt + (size_t)nxt.pn * tstep : cB;
        for (int t = 0; t < nt; t += 2) {
            const bool last = (t == nt - 2);
            const char* a1 = cA + (size_t)(t + 1) * kstep;
            const char* a2 = last ? nA : cA + (size_t)(t + 2) * kstep; const char* b2 = last ? nB : cB + (size_t)(t + 2) * kstep;
            const char* a3 = a2 + kstep; const char* b3 = b2 + kstep;
            PG8_LDB(B0, 0, 0); PG8_SCHED; PG8_LDA(At, 0, 0); PG8_STAGE(PG8_SA(1, 1), a1 + hstep, voffA);
            PG8_WAIT_L(8); PG8_BAR; PG8_WAIT_L(0); PG8_MMA(0, 0, At, B0); PG8_BAR; PG8_SCHED;
            PG8_LDB(B1, 0, 1); PG8_STAGE(PG8_SB(0, 0), b2, voffB);
            PG8_BAR; PG8_WAIT_L(0); PG8_MMA(0, 1, At, B1); PG8_BAR;
            PG8_LDA(At, 0, 1); PG8_STAGE(PG8_SA(0, 0), a2, voffA);
            PG8_BAR; PG8_WAIT_L(0); PG8_MMA(1, 0, At, B0); PG8_BAR; PG8_SCHED;
            PG8_STAGE(PG8_SB(0, 1), b2 + hstep, voffB);
            PG8_WAIT_V(6); PG8_BAR; PG8_MMA(1, 1, At, B1); PG8_BAR;
            PG8_LDB(B0, 1, 0); PG8_SCHED; PG8_LDA(At, 1, 0); PG8_STAGE(PG8_SA(0, 1), a2 + hstep, voffA);
            PG8_WAIT_L(8); PG8_BAR; PG8_WAIT_L(0); PG8_MMA(0, 0, At, B0); PG8_BAR; PG8_SCHED;
            PG8_LDB(B1, 1, 1); PG8_STAGE(PG8_SB(1, 0), b3, voffB);
            PG8_BAR; PG8_WAIT_L(0); PG8_MMA(0, 1, At, B1); PG8_BAR;
            PG8_LDA(At, 1, 1); PG8_STAGE(PG8_SA(1, 0), a3, voffA);
            PG8_BAR; PG8_WAIT_L(0); PG8_MMA(1, 0, At, B0); PG8_BAR; PG8_SCHED;
            PG8_STAGE(PG8_SB(1, 1), b3 + hstep, voffB);
            PG8_WAIT_V(6); PG8_BAR; PG8_MMA(1, 1, At, B1); PG8_BAR;
        }
        E(acc, cur, wr, wc, fr, fq);
        if (!has_next) break;
#pragma unroll
        for (int a = 0; a < 2; ++a)
#pragma unroll
            for (int b = 0; b < 2; ++b)
#pragma unroll
                for (int m = 0; m < 4; ++m)
#pragma unroll
                    for (int n = 0; n < 2; ++n) acc[a][b][m][n] = (f32x4){0.f, 0.f, 0.f, 0.f};
        cur = nxt; cA = nA; cB = nB; ++ui;
    }
    PG8_WAIT_V(0);
    if (wr == 0) PG8_BAR;
    PG8_BAR;
#undef PG8_SA
#undef PG8_SB
#undef PG8_STAGE
#undef PG8_LDA
#undef PG8_LDB
#undef PG8_MMA
#undef PG8_WAIT_V
#undef PG8_WAIT_L
#undef PG8_BAR
#undef PG8_SCHED
}

struct EpiSwiGLU {
    static constexpr bool PERM = true;
    bf16_t* O;
    __device__ __forceinline__ void operator()(const f32x4 (&acc)[2][2][4][2], const Unit& u, int wr, int wc, int fr, int fq) const {
        const int row0 = u.pm * BM + wr * 64 + fr, col0 = u.pn * 128 + wc * 32 + 8 * fq;
#pragma unroll
        for (int ai = 0; ai < 2; ++ai)
#pragma unroll
            for (int m = 0; m < 4; ++m) {
                bf16_t* rowp = O + (size_t)(row0 + ai * HALF + m * 16) * DFF + col0;
                f32x4 r0, r1;
#pragma unroll
                for (int j = 0; j < 4; ++j) {
                    const float a0 = acc[ai][0][m][0][j], a1 = acc[ai][0][m][1][j];
                    r0[j] = a0 * __builtin_amdgcn_rcpf(1.0f + __expf(-a0)) * acc[ai][1][m][0][j];
                    r1[j] = a1 * __builtin_amdgcn_rcpf(1.0f + __expf(-a1)) * acc[ai][1][m][1][j];
                }
                u32x4 w; w.x = cvt_pk_bf16(r0[0], r0[1]); w.y = cvt_pk_bf16(r0[2], r0[3]); w.z = cvt_pk_bf16(r1[0], r1[1]); w.w = cvt_pk_bf16(r1[2], r1[3]);
                *(u32x4*)rowp = w;
            }
    }
};
struct EpiResid {
    static constexpr bool PERM = false;
    float* X; float scale;
    __device__ __forceinline__ void operator()(const f32x4 (&acc)[2][2][4][2], const Unit& u, int wr, int wc, int fr, int fq) const {
        const int row0 = u.pm * BM + wr * 64 + fr, col0 = u.pn * BM + wc * 32 + 4 * fq;
#pragma unroll
        for (int ai = 0; ai < 2; ++ai)
#pragma unroll
            for (int m = 0; m < 4; ++m) { float* rowp = X + (size_t)(row0 + ai * HALF + m * 16) * D + col0;
#pragma unroll
                for (int bj = 0; bj < 2; ++bj)
#pragma unroll
                    for (int n = 0; n < 2; ++n) { f32x4* p = (f32x4*)(rowp + bj * HALF + n * 16); f32x4 x = *p; x += acc[ai][bj][m][n] * scale; *p = x; } }
    }
};
struct EpiProj {
    static constexpr bool PERM = true;
    bf16_t* O; bf16_t* halo;
    __device__ __forceinline__ void operator()(const f32x4 (&acc)[2][2][4][2], const Unit& u, int wr, int wc, int fr, int fq) const {
        const int row0 = u.pm * BM + wr * 64 + fr, col0 = u.pn * BM + wc * 32 + 8 * fq;
#pragma unroll
        for (int ai = 0; ai < 2; ++ai)
#pragma unroll
            for (int m = 0; m < 4; ++m) { const int row = row0 + ai * HALF + m * 16; bf16_t* rowp = O + (size_t)row * NIN + col0;
#pragma unroll
                for (int bj = 0; bj < 2; ++bj) { const f32x4 v0 = acc[ai][bj][m][0], v1 = acc[ai][bj][m][1];
                    u32x4 w; w.x = cvt_pk_bf16(v0[0], v0[1]); w.y = cvt_pk_bf16(v0[2], v0[3]); w.z = cvt_pk_bf16(v1[0], v1[1]); w.w = cvt_pk_bf16(v1[2], v1[3]);
                    *(u32x4*)(rowp + bj * HALF) = w;
                    if (m == 3 && fr >= 14) *(u32x4*)(halo + ((size_t)(row >> 6) * 2 + (row & 1)) * NIN + col0 + bj * HALF) = w; } }
    }
};
}

__device__ __forceinline__ void sample_gemm_splitk(const Ctx& p, unsigned char* lds, const bf16_t* A, const bf16_t* Bt, const int K, float* X, const float scale) {
    float* RED = (float*)lds;
    const int tid = p.tid, wid = tid >> 6, lane = tid & 63, fr = lane & 15, fq = lane >> 4;
    const int per = K / 256;
    for (int item = p.bid; item < 512; item += p.nb) {
        const int rt = item & 15, ct = item >> 4;
        const bf16_t* ap = A + (size_t)(MP + rt * 16 + fr) * K + 8 * fq + wid * per * 32;
        const bf16_t* b0 = Bt + (size_t)(ct * 32 + fr) * K + 8 * fq + wid * per * 32; const bf16_t* b1 = b0 + (size_t)16 * K;
        f32x4 acc0 = (f32x4){0.f, 0.f, 0.f, 0.f}, acc1 = acc0;
        for (int s0 = 0; s0 < per; s0 += 6) {
            bf16x8 a[6], x0[6], x1[6];
#pragma unroll
            for (int j = 0; j < 6; ++j) if (s0 + j < per) { a[j] = *(const bf16x8*)(ap + (s0 + j) * 32); x0[j] = *(const bf16x8*)(b0 + (s0 + j) * 32); x1[j] = *(const bf16x8*)(b1 + (s0 + j) * 32); }
#pragma unroll
            for (int j = 0; j < 6; ++j) if (s0 + j < per) {
                acc0 = __builtin_amdgcn_mfma_f32_16x16x32_bf16(x0[j], a[j], acc0, 0, 0, 0);
                acc1 = __builtin_amdgcn_mfma_f32_16x16x32_bf16(x1[j], a[j], acc1, 0, 0, 0);
            }
        }
        __syncthreads();
        *(f32x4*)(RED + (wid * 64 + lane) * 8) = acc0; *(f32x4*)(RED + (wid * 64 + lane) * 8 + 4) = acc1;
        __syncthreads();
        {
            const int ln = tid & 63, part = tid >> 6;
            float sum = 0.f;
#pragma unroll
            for (int w = 0; w < 8; ++w) sum += RED[(w * 64 + ln) * 8 + part];
            float* xp = X + (size_t)(MP + rt * 16 + (ln & 15)) * D + ct * 32 + (part >> 2) * 16 + 4 * (ln >> 4) + (part & 3);
            *xp += scale * sum;
        }
    }
}

__device__ __forceinline__ void tconv(unsigned char* lds, const float* src, int K, int N, int Npad, bf16_t* dst, int gu_half) {
    constexpr int NT = 2;
    float* tile = (float*)lds;
    const int t = threadIdx.x, tk = K >> 6, tn = Npad >> 6, ntile = tk * tn;
    for (int tl0 = blockIdx.x; tl0 < ntile; tl0 += NT * gridDim.x) {
        f32x4 v[NT][2];
#pragma unroll
        for (int u = 0; u < NT; ++u) {
            const int tl = tl0 + u * gridDim.x;
            if (tl < ntile) {
                const int k0 = (tl % tk) * 64, n0 = (tl / tk) * 64;
#pragma unroll
                for (int i = 0; i < 2; ++i) {
                    const int k = (t >> 4) + 32 * i, n4 = (t & 15) * 4;
                    v[u][i] = (f32x4){0.f, 0.f, 0.f, 0.f};
                    if (n0 + n4 < N) v[u][i] = *(const f32x4*)(src + (size_t)(k0 + k) * N + n0 + n4);
                }
            }
        }
        __syncthreads();
#pragma unroll
        for (int u = 0; u < NT; ++u) {
            if (tl0 + u * gridDim.x < ntile) {
#pragma unroll
                for (int i = 0; i < 2; ++i) {
                    const int k = (t >> 4) + 32 * i, n4 = (t & 15) * 4; float* tp = tile + u * (64 * 65) + k * 65 + n4;
                    tp[0] = v[u][i][0]; tp[1] = v[u][i][1]; tp[2] = v[u][i][2]; tp[3] = v[u][i][3];
                }
            }
        }
        __syncthreads();
#pragma unroll
        for (int u = 0; u < NT; ++u) {
            const int tl = tl0 + u * gridDim.x;
            if (tl < ntile) {
                const int k0 = (tl % tk) * 64, n0 = (tl / tk) * 64;
                const int n = t >> 3, kc = (t & 7) * 8; const float* tp = tile + u * (64 * 65);
                u32x4 w;
                w.x = cvt_pk_bf16(tp[(kc + 0) * 65 + n], tp[(kc + 1) * 65 + n]); w.y = cvt_pk_bf16(tp[(kc + 2) * 65 + n], tp[(kc + 3) * 65 + n]);
                w.z = cvt_pk_bf16(tp[(kc + 4) * 65 + n], tp[(kc + 5) * 65 + n]); w.w = cvt_pk_bf16(tp[(kc + 6) * 65 + n], tp[(kc + 7) * 65 + n]);
                const int nn = n0 + n, drow = gu_half < 0 ? nn : (((nn >> 7) << 8) + gu_half * 128 + (nn & 127));
                *(u32x4*)(dst + (size_t)drow * K + k0 + kc) = w;
            }
        }
    }
}
__device__ __forceinline__ bf16_t* wl_base(unsigned char* ws, int L) { return (bf16_t*)(ws + WS_WB) + (size_t)L * WL_E; }
__device__ __forceinline__ bf16_t* w_gu(unsigned char* ws, int L, int sub) { return wl_base(ws, L) + (size_t)sub * (GU_E + DN_E); }
__device__ __forceinline__ bf16_t* w_dn(unsigned char* ws, int L, int sub) { return w_gu(ws, L, sub) + GU_E; }
__device__ __forceinline__ bf16_t* w_in(unsigned char* ws, int L) { return wl_base(ws, L) + 2 * (GU_E + DN_E); }
__device__ __forceinline__ bf16_t* w_out(unsigned char* ws, int L) { return w_in(ws, L) + IN_E; }
__device__ __forceinline__ bf16_t* w_small(unsigned char* ws, int i) { return (bf16_t*)(ws + WS_SMALL) + (size_t)i * SMALL_E; }

__device__ void phase_init(const Params& p, unsigned char* lds) {
    {
        const f32x4* s0 = (const f32x4*)p.in[0]; const f32x4* s1 = (const f32x4*)p.in[1]; f32x4* d = (f32x4*)p.out;
        const size_t n0 = (size_t)MP * D / 4, n1 = (size_t)MS * D / 4, st = (size_t)gridDim.x * blockDim.x;
        for (size_t i = (size_t)blockIdx.x * blockDim.x + threadIdx.x; i < n0 + n1; i += st) d[i] = i < n0 ? s0[i] : s1[i - n0];
    }
    {
        float* par = (float*)(p.ws + WS_PAR);
        const size_t st = (size_t)gridDim.x * blockDim.x, t0 = (size_t)blockIdx.x * blockDim.x + threadIdx.x;
#pragma unroll
        for (int k = 0; k < NPAR; ++k) {
            const f32x4* src = (const f32x4*)p.in[PIDX[k]]; f32x4* dst = (f32x4*)(par + par_off(PIDX[k]));
            for (size_t e = t0; e < PSZ[k] / 4; e += st) dst[e] = src[e];
        }
    }
    for (int L = 0; L < 4; ++L) {
        const int i = L >> 1;
        for (int sub = 0; sub < 2; ++sub) {
            const size_t o = (size_t)(L * 2 + sub) * 1024 * 2816;
            tconv(lds, p.in[7] + o, 1024, 2816, 2816, w_gu(p.ws, L, sub), 0);
            tconv(lds, p.in[8] + o, 1024, 2816, 2816, w_gu(p.ws, L, sub), 1);
            tconv(lds, p.in[9] + o, 2816, 1024, 1024, w_dn(p.ws, L, sub), -1);
        }
        if ((L & 1) == 0) {
            tconv(lds, p.in[11] + (size_t)i * 1024 * 3328, 1024, 3328, 3328, w_in(p.ws, L), -1);
            tconv(lds, p.in[12] + (size_t)i * 1024 * 1024, 1024, 1024, 1024, w_out(p.ws, L), -1);
            tconv(lds, p.in[15] + (size_t)i * 64 * 512, 64, 512, 512, w_small(p.ws, i), -1);
            tconv(lds, p.in[17] + (size_t)i * 64 * 512, 64, 512, 512, w_small(p.ws, i) + 512 * 64, -1);
            tconv(lds, p.in[18] + (size_t)i * 128 * 512, 128, 512, 512, w_small(p.ws, i) + 2 * 512 * 64, -1);
        } else {
            tconv(lds, p.in[25] + (size_t)i * 1024 * 3088, 1024, 3088, 3328, w_in(p.ws, L), -1);
            tconv(lds, p.in[26] + (size_t)i * 1024 * 1024, 1024, 1024, 1024, w_out(p.ws, L), -1);
        }
    }
}

__device__ void phase_norm(const Ctx& p, const float* X, const float* g, bf16_t* H) {
    const int lane = p.tid & 63, wv = (p.bid * 512 + p.tid) >> 6, nw = (p.nb * 512) >> 6;
    f32x4 gv[4];
#pragma unroll
    for (int i = 0; i < 4; ++i) gv[i] = *(const f32x4*)(g + (lane + 64 * i) * 4);
    for (int row = wv; row < MT; row += 2 * nw) {
        const int row1 = row + nw; const bool has1 = row1 < MT;
        const f32x4* x0 = (const f32x4*)(X + (size_t)row * D); const f32x4* x1 = (const f32x4*)(X + (size_t)(has1 ? row1 : row) * D);
        f32x4 v0[4], v1[4];
#pragma unroll
        for (int i = 0; i < 4; ++i) { v0[i] = x0[lane + 64 * i]; v1[i] = x1[lane + 64 * i]; }
        float s0 = 0.f, s1 = 0.f;
#pragma unroll
        for (int i = 0; i < 4; ++i) { s0 += v0[i][0] * v0[i][0] + v0[i][1] * v0[i][1] + v0[i][2] * v0[i][2] + v0[i][3] * v0[i][3]; s1 += v1[i][0] * v1[i][0] + v1[i][1] * v1[i][1] + v1[i][2] * v1[i][2] + v1[i][3] * v1[i][3]; }
#pragma unroll
        for (int o = 32; o > 0; o >>= 1) { s0 += __shfl_xor(s0, o); s1 += __shfl_xor(s1, o); }
        const float r0 = rsqrtf(s0 * (1.0f / 1024.0f) + 1e-6f), r1 = rsqrtf(s1 * (1.0f / 1024.0f) + 1e-6f);
#pragma unroll
        for (int i = 0; i < 4; ++i) *(u32x2*)(H + (size_t)row * D + (lane + 64 * i) * 4) = pack4(v0[i] * r0 * gv[i]);
        if (has1) {
#pragma unroll
            for (int i = 0; i < 4; ++i) *(u32x2*)(H + (size_t)row1 * D + (lane + 64 * i) * 4) = pack4(v1[i] * r1 * gv[i]);
        }
    }
}
__device__ void phase_final_norm(const Ctx& p, float* X, const float* g) {
    const int lane = p.tid & 63, wv = (p.bid * 512 + p.tid) >> 6, nw = (p.nb * 512) >> 6;
    f32x4 gv[4];
#pragma unroll
    for (int i = 0; i < 4; ++i) gv[i] = *(const f32x4*)(g + (lane + 64 * i) * 4);
    for (int row = wv; row < MT; row += nw) {
        f32x4* x = (f32x4*)(X + (size_t)row * D);
        f32x4 v[4]; float ss = 0.f;
#pragma unroll
        for (int i = 0; i < 4; ++i) { v[i] = x[lane + 64 * i]; ss += v[i][0] * v[i][0] + v[i][1] * v[i][1] + v[i][2] * v[i][2] + v[i][3] * v[i][3]; }
        ss = wave_sum(ss);
        const float rs = rsqrtf(ss * (1.0f / 1024.0f) + 1e-6f);
#pragma unroll
        for (int i = 0; i < 4; ++i) x[lane + 64 * i] = v[i] * rs * gv[i];
    }
}

struct RowInfo { int t, b, smp, len; };
__device__ __forceinline__ RowInfo row_info(int row) {
    RowInfo r;
    if (row < MP) { r.t = row & (SEQ - 1); r.b = row >> 14; r.smp = 0; r.len = SEQ; }
    else { const int q = row - MP; r.t = q & 31; r.b = q >> 5; r.smp = 1; r.len = DSEQ; }
    return r;
}

__device__ void phase_even_prep(const Ctx& p, unsigned char* lds, int i) {
    bf16_t* PROJ = (bf16_t*)(p.ws + WS_BIG);
    const bf16_t* HALO = (const bf16_t*)(p.ws + WS_HALO);
    bf16_t* YC = (bf16_t*)(p.ws + WS_H);
    float* SCAL = (float*)(p.ws + WS_SCAL);
    const float* st_shift = PAR(2) + (size_t)i * 8 * 1792;
    const float* st_conv = PAR(4) + (size_t)i * 8 * 2 * 512;
    const float* mu = PAR(13) + (size_t)i * 1792;
    const float* cw = PAR(24) + (size_t)i * 3 * 512;
    const bf16_t* wupT = w_small(p.ws, i); const bf16_t* aupT = wupT + 512 * 64; const bf16_t* gupT = wupT + 2 * 512 * 64;
    const int tid = p.tid, wid = tid >> 6, lane = tid & 63, fr = lane & 15, fq = lane >> 4;
    float* CST = (float*)lds;
    bf16_t* AW = (bf16_t*)(lds + 16384); bf16_t* AA = AW + 64 * 72; bf16_t* AG = AA + 64 * 72;
    {
        const int c = tid;
        CST[0 * 512 + c] = mu[c]; CST[1 * 512 + c] = mu[512 + c]; CST[2 * 512 + c] = mu[1024 + c];
        CST[3 * 512 + c] = (PAR(14) + i * 512)[c]; CST[4 * 512 + c] = (PAR(16) + i * 512)[c];
        CST[5 * 512 + c] = (PAR(19) + i * 512)[c]; CST[6 * 512 + c] = (PAR(20) + i * 512)[c]; CST[7 * 512 + c] = (PAR(21) + i * 512)[c];
    }
    const int th = tid >> 8;
    for (int tile = p.bid; tile < MT / 64; tile += p.nb) {
        const int row0 = tile * 64;
        __syncthreads();
        {
            const int cp2 = (tid & 255) * 2;
            const f32x2 cw0 = *(const f32x2*)(cw + cp2), cw1 = *(const f32x2*)(cw + 512 + cp2), cw2 = *(const f32x2*)(cw + 1024 + cp2);
            const int tk0 = th * 32, rowa = row0 + tk0; const RowInfo ra = row_info(rowa);
            f32x2 u1, u2;
            if (ra.t == 0) {
                if (ra.smp) { u2 = *(const f32x2*)(st_conv + (size_t)ra.b * 1024 + cp2); u1 = *(const f32x2*)(st_conv + (size_t)ra.b * 1024 + 512 + cp2); }
                else { u1 = (f32x2){0.f, 0.f}; u2 = u1; }
            } else {
                const bf16_t* h0 = (th == 0) ? HALO + ((size_t)(tile - 1) * 2) * NIN : PROJ + (size_t)(rowa - 2) * NIN; const bf16_t* h1 = h0 + NIN;
                const unsigned a0_ = *(const unsigned*)(h0 + 2304 + cp2), b0_ = *(const unsigned*)(h0 + 2816 + cp2), a1_ = *(const unsigned*)(h1 + 2304 + cp2), b1_ = *(const unsigned*)(h1 + 2816 + cp2);
                u2 = (f32x2){bflo(a0_) * bflo(b0_), bfhi(a0_) * bfhi(b0_)}; u1 = (f32x2){bflo(a1_) * bflo(b1_), bfhi(a1_) * bfhi(b1_)};
            }
            float* oc = p.out + (ra.smp ? O_SCONV + (size_t)(i * 8 + ra.b) * 1024 : O_PCONV + (size_t)(i * 2 + ra.b) * 1024);
#pragma unroll 1
            for (int bt = 0; bt < 4; ++bt) {
                unsigned gb[8], gc[8], hb[8];
#pragma unroll
                for (int j = 0; j < 8; ++j) { const bf16_t* pr = PROJ + (size_t)(rowa + bt * 8 + j) * NIN; gb[j] = *(const unsigned*)(pr + 1792 + cp2); gc[j] = *(const unsigned*)(pr + 2304 + cp2); hb[j] = *(const unsigned*)(pr + 2816 + cp2); }
                unsigned yo[8];
#pragma unroll
                for (int j = 0; j < 8; ++j) {
                    const f32x2 u0 = (f32x2){bflo(gc[j]) * bflo(hb[j]), bfhi(gc[j]) * bfhi(hb[j])};
                    const f32x2 y = (f32x2){bflo(gb[j]), bfhi(gb[j])} * (cw0 * u2 + cw1 * u1 + cw2 * u0);
                    yo[j] = cvt_pk_bf16(y.x, y.y);
                    const int t = ra.t + bt * 8 + j;
                    if (t >= ra.len - 2) *(f32x2*)(oc + (t - (ra.len - 2)) * 512 + cp2) = u0;
                    u2 = u1; u1 = u0;
                }
#pragma unroll
                for (int j = 0; j < 8; ++j) *(unsigned*)(YC + (size_t)(rowa + bt * 8 + j) * D + 512 + cp2) = yo[j];
            }
        }
        {
            const int lcol = tid & 255, pc = 1536 + lcol; const float mu_l = mu[pc];
            const int tk0 = th * 32, rowa = row0 + tk0; const RowInfo ra = row_info(rowa);
            float prev;
            if (ra.t == 0) prev = ra.smp ? st_shift[(size_t)ra.b * 1792 + pc] : 0.f;
            else prev = (th == 0) ? bf2f(HALO[((size_t)(tile - 1) * 2 + 1) * NIN + pc]) : bf2f(PROJ[(size_t)(rowa - 1) * NIN + pc]);
            bf16_t cu[32];
#pragma unroll
            for (int j = 0; j < 32; ++j) cu[j] = PROJ[(size_t)(rowa + j) * NIN + pc];
#pragma unroll
            for (int j = 0; j < 32; ++j) {
                const int tk = tk0 + j; const float cur = bf2f(cu[j]);
                const float xs = cur + (prev - cur) * mu_l;
                if (lcol < 64) AW[tk * 72 + lcol] = f2bf(tanhf(xs));
                else if (lcol < 128) AA[tk * 72 + lcol - 64] = f2bf(xs);
                else AG[((lcol - 128) >> 6) * (64 * 72) + tk * 72 + ((lcol - 128) & 63)] = f2bf(sigmoidf_(xs));
                prev = cur;
            }
            if (ra.t + 31 == ra.len - 1) p.out[(ra.smp ? O_SSHIFT + (size_t)(i * 8 + ra.b) * 1792 : O_PSHIFT + (size_t)(i * 2 + ra.b) * 1792) + pc] = prev;
        }
        __syncthreads();
        {
            const int h = wid;
            float a_n2[4] = {0.f, 0.f, 0.f, 0.f}, a_s1[4] = {0.f, 0.f, 0.f, 0.f}, a_s2[4] = {0.f, 0.f, 0.f, 0.f}, a_sb[4] = {0.f, 0.f, 0.f, 0.f};
#pragma unroll 1
            for (int n = 0; n < 4; ++n) {
                const int c = h * 64 + n * 16 + 4 * fq;
                bf16x8 bw[2], ba[2], bg[4];
#pragma unroll
                for (int ks = 0; ks < 2; ++ks) { bw[ks] = *(const bf16x8*)(wupT + (size_t)(h * 64 + n * 16 + fr) * 64 + ks * 32 + fq * 8); ba[ks] = *(const bf16x8*)(aupT + (size_t)(h * 64 + n * 16 + fr) * 64 + ks * 32 + fq * 8); }
#pragma unroll
                for (int ks = 0; ks < 4; ++ks) bg[ks] = *(const bf16x8*)(gupT + (size_t)(h * 64 + n * 16 + fr) * 128 + ks * 32 + fq * 8);
                u32x2 rc[2][3], rq[2][3];
#pragma unroll 1
                for (int m = 3; m >= 0; --m) {
                    if (m & 1) {
#pragma unroll
                        for (int mm = 0; mm < 2; ++mm) {
                            const int tk = (m - 1 + mm) * 16 + fr, row = row0 + tk; const RowInfo ri = row_info(row);
                            const bf16_t* pr = PROJ + (size_t)row * NIN + c;
#pragma unroll
                            for (int a = 0; a < 3; ++a) rc[mm][a] = *(const u32x2*)(pr + a * 512);
                            if (ri.t == 0) {
                                if (ri.smp) { const float* pf = st_shift + (size_t)ri.b * 1792 + c;
#pragma unroll
                                    for (int a = 0; a < 3; ++a) rq[mm][a] = pack4(*(const f32x4*)(pf + a * 512)); }
                                else {
#pragma unroll
                                    for (int a = 0; a < 3; ++a) rq[mm][a] = (u32x2){0u, 0u}; }
                            } else {
                                const bf16_t* pb = ((tk == 0) ? HALO + ((size_t)(tile - 1) * 2 + 1) * NIN : PROJ + (size_t)(row - 1) * NIN) + c;
#pragma unroll
                                for (int a = 0; a < 3; ++a) rq[mm][a] = *(const u32x2*)(pb + a * 512);
                            }
                        }
                    }
                    f32x4 in_c[3], in_q[3];
#pragma unroll
                    for (int a = 0; a < 3; ++a) {
                        const bool od = (m & 1) != 0;
                        u32x2 sc, sq; sc.x = od ? rc[1][a].x : rc[0][a].x; sc.y = od ? rc[1][a].y : rc[0][a].y; sq.x = od ? rq[1][a].x : rq[0][a].x; sq.y = od ? rq[1][a].y : rq[0][a].y;
                        in_c[a] = unpack4(sc); in_q[a] = unpack4(sq);
                    }
                    const f32x4 mur = *(const f32x4*)(CST + 0 * 512 + c), muk = *(const f32x4*)(CST + 1 * 512 + c), muv = *(const f32x4*)(CST + 2 * 512 + c), w0v = *(const f32x4*)(CST + 3 * 512 + c),
                                a0v = *(const f32x4*)(CST + 4 * 512 + c), kkv = *(const f32x4*)(CST + 5 * 512 + c), kav = *(const f32x4*)(CST + 6 * 512 + c), rkv = *(const f32x4*)(CST + 7 * 512 + c);
                    f32x4 dwn = (f32x4){0.f, 0.f, 0.f, 0.f}, dan = dwn, dgn = dwn;
#pragma unroll
                    for (int ks = 0; ks < 2; ++ks) {
                        const bf16x8 aw = *(const bf16x8*)(AW + (m * 16 + fr) * 72 + ks * 32 + fq * 8);
                        const bf16x8 aa = *(const bf16x8*)(AA + (m * 16 + fr) * 72 + ks * 32 + fq * 8);
                        dwn = __builtin_amdgcn_mfma_f32_16x16x32_bf16(bw[ks], aw, dwn, 0, 0, 0);
                        dan = __builtin_amdgcn_mfma_f32_16x16x32_bf16(ba[ks], aa, dan, 0, 0, 0);
                    }
#pragma unroll
                    for (int ks = 0; ks < 4; ++ks) {
                        const bf16x8 ag = *(const bf16x8*)(AG + (ks >> 1) * (64 * 72) + (m * 16 + fr) * 72 + (ks & 1) * 32 + fq * 8);
                        dgn = __builtin_amdgcn_mfma_f32_16x16x32_bf16(bg[ks], ag, dgn, 0, 0, 0);
                    }
                    const int tk = m * 16 + fr, row = row0 + tk; const RowInfo ri = row_info(row);
                    bf16_t* pr = PROJ + (size_t)row * NIN;
                    if (ri.t == ri.len - 1) {
                        float* osh = p.out + (ri.smp ? O_SSHIFT + (size_t)(i * 8 + ri.b) * 1792 : O_PSHIFT + (size_t)(i * 2 + ri.b) * 1792);
                        *(f32x4*)(osh + c) = in_c[0]; *(f32x4*)(osh + 512 + c) = in_c[1]; *(f32x4*)(osh + 1024 + c) = in_c[2];
                    }
                    const f32x4 xr = in_c[0] + (in_q[0] - in_c[0]) * mur, xk = in_c[1] + (in_q[1] - in_c[1]) * muk, xv = in_c[2] + (in_q[2] - in_c[2]) * muv;
                    f32x4 e, a; float t_n2 = 0.f, t_s1 = 0.f, t_s2 = 0.f, t_sb = 0.f;
#pragma unroll
                    for (int j = 0; j < 4; ++j) {
                        e[j] = sigmoidf_(w0v[j] + dwn[j]) * 0.60653065971f;
                        a[j] = sigmoidf_(a0v[j] + dan[j]);
                        const float kkr = xk[j] * kkv[j], kef = xk[j] * (1.0f + (a[j] - 1.0f) * kav[j]);
                        t_n2 += kkr * kkr; t_s1 += kkr * a[j] * xr[j]; t_s2 += kef * xr[j]; t_sb += xr[j] * kef * rkv[j];
                    }
#pragma unroll
                    for (int mm = 0; mm < 4; ++mm) { const bool on = (mm == m); a_n2[mm] += on ? t_n2 : 0.f; a_s1[mm] += on ? t_s1 : 0.f; a_s2[mm] += on ? t_s2 : 0.f; a_sb[mm] += on ? t_sb : 0.f; }
                    *(u32x2*)(pr + c) = pack4(xr); *(u32x2*)(pr + 512 + c) = pack4(xk); *(u32x2*)(pr + 1024 + c) = pack4(xv);
                    *(u32x2*)(pr + 1792 + c) = pack4(e); *(u32x2*)(pr + 2304 + c) = pack4(a); *(u32x2*)(pr + 2816 + c) = pack4(dgn);
                }
            }
#pragma unroll
            for (int m = 0; m < 4; ++m) {
                float n2 = a_n2[m], s1 = a_s1[m], s2 = a_s2[m], sb = a_sb[m];
                n2 += __shfl_xor(n2, 16); n2 += __shfl_xor(n2, 32);
                s1 += __shfl_xor(s1, 16); s1 += __shfl_xor(s1, 32);
                s2 += __shfl_xor(s2, 16); s2 += __shfl_xor(s2, 32);
                sb += __shfl_xor(sb, 16); sb += __shfl_xor(sb, 32);
                if (fq == 0) { const float inv = 1.0f / fmaxf(sqrtf(n2), 1e-12f); *(f32x4*)(SCAL + ((size_t)(row0 + m * 16 + fr) * 8 + h) * 4) = (f32x4){inv, s1 * inv, s2, sb}; }
            }
        }
    }
}

__device__ __forceinline__ void scan_consume(float& s, const f32x4* Q4, const float* KE, int lane, float vv, float c1, float c2, float& yout) {
    float rec0 = 0.f, rec1 = 0.f;
    const int l15 = lane & 15;
    f32x4 qa[4]; float ka[4];
#pragma unroll
    for (int u = 0; u < 4; ++u) { qa[u] = Q4[u * 64 + lane]; ka[u] = KE[u * 64 + lane]; }
#pragma unroll
    for (int g = 0; g < 8; ++g) {
        f32x4 qb[4]; float kb[4];
        if (g + 1 < 8) {
#pragma unroll
            for (int u = 0; u < 4; ++u) { qb[u] = Q4[((g + 1) * 4 + u) * 64 + lane]; kb[u] = KE[((g + 1) * 4 + u) * 64 + lane]; }
        }
#pragma unroll
        for (int u = 0; u < 4; ++u) {
            const int tt = g * 4 + u;
            const f32x4 q = qa[u];
            const float p1 = s * q[0], p2 = s * q[1];
            auto r = __builtin_amdgcn_permlane32_swap(__float_as_uint(p1), __float_as_uint(p2), false, false);
            float x = __uint_as_float(r[0]) + __uint_as_float(r[1]);
            x += dppf<0xB1>(x); x += dppf<0x4E>(x); x += dppf<0x141>(x); x += dppf<0x140>(x);
            const float sa0 = __int_as_float(__builtin_amdgcn_readlane(__float_as_int(x), 0));
            const float sa1 = __int_as_float(__builtin_amdgcn_readlane(__float_as_int(x), 16));
            const float vt = __int_as_float(__builtin_amdgcn_readlane(__float_as_int(vv), tt));
            float sn = fmaf(s, q[2], vt * ka[u]);
            sn = fmaf(-sa0, q[3], sn); s = fmaf(-sa1, q[3], sn);
            if (tt < 16) rec0 = (l15 == (tt & 15)) ? x : rec0; else rec1 = (l15 == (tt & 15)) ? x : rec1;
        }
        if (g + 1 < 8) {
#pragma unroll
            for (int u = 0; u < 4; ++u) { qa[u] = qb[u]; ka[u] = kb[u]; }
        }
    }
    const float a0 = __shfl(rec0, l15), a1 = __shfl(rec0, 16 + l15), b0 = __shfl(rec0, 32 + l15), b1 = __shfl(rec0, 48 + l15);
    const float a2 = __shfl(rec1, l15), a3 = __shfl(rec1, 16 + l15), b2 = __shfl(rec1, 32 + l15), b3 = __shfl(rec1, 48 + l15);
    const float sav = (lane < 16) ? a0 + a1 : a2 + a3, yav = (lane < 16) ? b0 + b1 : b2 + b3;
    yout = yav - sav * c1 + vv * c2;
}
__device__ void phase_scan(const Ctx& p, unsigned char* lds, int i) {
    const bf16_t* PROJ = (const bf16_t*)(p.ws + WS_BIG);
    bf16_t* YC = (bf16_t*)(p.ws + WS_H);
    const float* SCAL = (const float*)(p.ws + WS_SCAL);
    const float* k_k = PAR(19) + i * 512; const float* k_a = PAR(20) + i * 512;
    const int tid = p.tid, wid = tid >> 6, lane = tid & 63;
    f32x4* Q4 = (f32x4*)lds;
    float* KE = (float*)(lds + 65536);
    for (int job = p.bid; job < 512; job += p.nb) {
        int seq, h, rbase, rpw;
        if (job < 256) { seq = job >> 7; h = (job >> 4) & 7; rbase = (job & 15) * 4; rpw = 1; }
        else { const int j = job - 256; seq = 2 + (j >> 5); h = (j >> 2) & 7; rbase = (j & 3) * 16; rpw = 4; }
        const int smp = seq >= 2, b = smp ? seq - 2 : seq, row0 = smp ? MP + b * 32 : b * SEQ, len = smp ? DSEQ : SEQ, nch = len >> 5;
        const float* s_init = smp ? PAR(3) + ((size_t)(i * 8 + b) * 8 + h) * 4096 : nullptr;
        float* s_out = p.out + (smp ? O_SWKV + ((size_t)(i * 8 + b) * 8 + h) * 4096 : O_PWKV + ((size_t)(i * 2 + b) * 8 + h) * 4096);
        __syncthreads();
        if (wid >= 4) {
            const int pw = wid - 4, col = h * 64 + lane;
            const float kkc = k_k[col], kac = k_a[col];
            unsigned rxr[8], rxk[8], re[8], ra[8]; float rinv[8];
            auto load_raw = [&](int c) {
#pragma unroll
                for (int ii = 0; ii < 8; ++ii) {
                    const int row = row0 + c * 32 + pw * 8 + ii; const bf16_t* pr = PROJ + (size_t)row * NIN;
                    rxr[ii] = pr[col]; rxk[ii] = pr[512 + col]; re[ii] = pr[1792 + col]; ra[ii] = pr[2304 + col];
                    rinv[ii] = SCAL[((size_t)row * 8 + h) * 4];
                }
            };
            auto write_lds = [&](int c) {
                f32x4* q = Q4 + (c & 1) * 2048; float* ke = KE + (c & 1) * 2048;
#pragma unroll
                for (int ii = 0; ii < 8; ++ii) {
                    const int tt = pw * 8 + ii;
                    const float xr = bf2f((bf16_t)rxr[ii]), xk = bf2f((bf16_t)rxk[ii]), e = bf2f((bf16_t)re[ii]), a = bf2f((bf16_t)ra[ii]);
                    const float kk = xk * kkc * rinv[ii], w = __expf(-e);
                    q[tt * 64 + lane] = (f32x4){kk, w * xr, w, kk * a};
                    ke[tt * 64 + lane] = xk * (1.0f + (a - 1.0f) * kac);
                }
            };
            load_raw(0);
            for (int c = 0; c <= nch; ++c) {
                if (c < nch) {
                    write_lds(c);
                    if (c + 1 < nch) load_raw(c + 1);
                }
                __syncthreads();
            }
        } else if (rpw == 1) {
            __builtin_amdgcn_s_setprio(3);
            const int vrow = rbase + wid, vcol = 1024 + h * 64 + vrow;
            float s = s_init ? s_init[vrow * 64 + lane] : 0.f;
            float vv = 0.f, c1 = 0.f, c2 = 0.f;
            if (lane < 32) { const int row = row0 + lane; vv = bf2f(PROJ[(size_t)row * NIN + vcol]); const float* sc = SCAL + ((size_t)row * 8 + h) * 4; c1 = sc[1]; c2 = sc[2]; }
            __syncthreads();
            for (int c = 0; c < nch; ++c) {
                float vn = 0.f, c1n = 0.f, c2n = 0.f;
                if (c + 1 < nch && lane < 32) { const int row = row0 + (c + 1) * 32 + lane; vn = bf2f(PROJ[(size_t)row * NIN + vcol]); const float* sc = SCAL + ((size_t)row * 8 + h) * 4; c1n = sc[1]; c2n = sc[2]; }
                float y;
                scan_consume(s, Q4 + (c & 1) * 2048, KE + (c & 1) * 2048, lane, vv, c1, c2, y);
                if (lane < 32) YC[(size_t)(row0 + c * 32 + lane) * D + h * 64 + vrow] = f2bf(y);
                vv = vn; c1 = c1n; c2 = c2n;
                __syncthreads();
            }
            s_out[vrow * 64 + lane] = s;
            __builtin_amdgcn_s_setprio(0);
        } else {
            __syncthreads();
            for (int r = 0; r < 4; ++r) {
                const int vrow = rbase + wid * 4 + r, vcol = 1024 + h * 64 + vrow;
                float s = s_init[vrow * 64 + lane];
                float vv = 0.f, c1 = 0.f, c2 = 0.f;
                if (lane < 32) { const int row = row0 + lane; vv = bf2f(PROJ[(size_t)row * NIN + vcol]); const float* sc = SCAL + ((size_t)row * 8 + h) * 4; c1 = sc[1]; c2 = sc[2]; }
                float y;
                scan_consume(s, Q4, KE, lane, vv, c1, c2, y);
                if (lane < 32) YC[(size_t)(row0 + lane) * D + h * 64 + vrow] = f2bf(y);
                s_out[vrow * 64 + lane] = s;
            }
            __syncthreads();
        }
    }
}

__device__ void phase_even_post(const Ctx& p, int i) {
    const bf16_t* PROJ = (const bf16_t*)(p.ws + WS_BIG);
    bf16_t* YC = (bf16_t*)(p.ws + WS_H);
    const float* SCAL = (const float*)(p.ws + WS_SCAL);
    const float* lnw = PAR(22) + i * 512; const float* lnb = PAR(23) + i * 512;
    const int lane = p.tid & 63, wv = (p.bid * 512 + p.tid) >> 6, nw = (p.nb * 512) >> 6;
    const int l16 = lane & 15, sub = lane >> 4;
    constexpr int NB = 4;
    for (int g0 = wv * 4; g0 < MT * 8; g0 += nw * 4 * NB) {
        u32x2 yy[NB], vv[NB], gg[NB]; float cb[NB]; int rw[NB], cc[NB]; bool ok[NB];
#pragma unroll
        for (int k = 0; k < NB; ++k) {
            const int g = g0 + k * nw * 4 + sub; ok[k] = g < MT * 8; const int gc = ok[k] ? g : g0 + sub;
            rw[k] = gc >> 3; const int h = gc & 7; cc[k] = h * 64 + l16 * 4;
            yy[k] = *(const u32x2*)(YC + (size_t)rw[k] * D + cc[k]);
            vv[k] = *(const u32x2*)(PROJ + (size_t)rw[k] * NIN + 1024 + cc[k]); gg[k] = *(const u32x2*)(PROJ + (size_t)rw[k] * NIN + 2816 + cc[k]);
            cb[k] = SCAL[((size_t)rw[k] * 8 + h) * 4 + 3];
        }
        u32x2 oo[NB];
#pragma unroll
        for (int k = 0; k < NB; ++k) {
            const f32x4 y = unpack4(yy[k]);
            float sm = y[0] + y[1] + y[2] + y[3];
            sm += __shfl_xor(sm, 1); sm += __shfl_xor(sm, 2); sm += __shfl_xor(sm, 4); sm += __shfl_xor(sm, 8);
            const float mean = sm * (1.0f / 64.0f);
            const f32x4 d = y - mean;
            float vr = d[0] * d[0] + d[1] * d[1] + d[2] * d[2] + d[3] * d[3];
            vr += __shfl_xor(vr, 1); vr += __shfl_xor(vr, 2); vr += __shfl_xor(vr, 4); vr += __shfl_xor(vr, 8);
            const float rs = rsqrtf(vr * (1.0f / 64.0f) + 64e-5f);
            const f32x4 o = (d * rs * *(const f32x4*)(lnw + cc[k]) + *(const f32x4*)(lnb + cc[k]) + unpack4(vv[k]) * cb[k]) * unpack4(gg[k]);
            oo[k] = pack4(o);
        }
#pragma unroll
        for (int k = 0; k < NB; ++k) if (ok[k]) *(u32x2*)(YC + (size_t)rw[k] * D + cc[k]) = oo[k];
    }
}

__device__ __forceinline__ void chunk_info(int ch, int& row0, int& L) { if (ch < 512) { row0 = ch * 64; L = 64; } else { row0 = MP + (ch - 512) * 32; L = 32; } }
__device__ void phase_gla_intra(const Ctx& p, unsigned char* lds, int i) {
    bf16_t* PROJ = (bf16_t*)(p.ws + WS_BIG);
    bf16_t* OB = (bf16_t*)(p.ws + WS_H);
    float* DEC = (float*)(p.ws + WS_DEC);
    const float* a_up = PAR(27) + (size_t)i * 16 * 512; const float* a_b = PAR(28) + i * 512;
    const int tid = p.tid, wid = tid >> 6, lane = tid & 63, fr = lane & 15, fq = lane >> 4;
    bf16_t* QD = (bf16_t*)lds;
    bf16_t* KD = QD + 64 * 136;
    bf16_t* VT = KD + 64 * 136;
    bf16_t* SC = VT + 256 * 72;
    bf16_t* KE = SC + 64 * 72;
    float* ALO = (float*)(KE + 128 * 72);
    float* PS = ALO + 64 * 16;
    for (int item = p.bid; item < 520 * 4; item += p.nb) {
        const int ch = item >> 2, h = item & 3; int row0, L; chunk_info(ch, row0, L);
        __syncthreads();
        for (int e = tid; e < 64 * 16; e += 512) { const int tk = e >> 4, j = e & 15; ALO[e] = tk < L ? bf2f(PROJ[(size_t)(row0 + tk) * NIN + 3072 + j]) : 0.f; }
        for (int e = tid; e < 64 * 64; e += 512) {
            const int tk = e >> 6, d4 = (e & 63) * 4;
            u32x2 v = (u32x2){0u, 0u};
            if (tk < L) v = *(const u32x2*)(PROJ + (size_t)(row0 + tk) * NIN + 1024 + h * 256 + d4);
            VT[(d4 + 0) * 72 + tk] = (bf16_t)(v.x & 0xffffu); VT[(d4 + 1) * 72 + tk] = (bf16_t)(v.x >> 16);
            VT[(d4 + 2) * 72 + tk] = (bf16_t)(v.y & 0xffffu); VT[(d4 + 3) * 72 + tk] = (bf16_t)(v.y >> 16);
        }
        __syncthreads();
        {
            const int col = tid & 127, qr = tid >> 7, gc = h * 128 + col;
            float wv[16];
#pragma unroll
            for (int j = 0; j < 16; ++j) wv[j] = a_up[j * 512 + gc];
            const float bias = a_b[gc];
            float cum[16]; float run = 0.f;
#pragma unroll
            for (int t = 0; t < 16; ++t) {
                const int tk = qr * 16 + t;
                float x = bias;
#pragma unroll
                for (int j = 0; j < 16; ++j) x += ALO[tk * 16 + j] * wv[j];
                const float la = tk < L ? (fminf(x, 0.f) - __logf(1.0f + __expf(-fabsf(x)))) * (1.0f / 16.0f) : 0.f;
                run += la; cum[t] = run;
            }
            PS[qr * 128 + col] = run;
            __syncthreads();
            float pre = 0.f, tot = 0.f;
#pragma unroll
            for (int q = 0; q < 4; ++q) { const float v = PS[q * 128 + col]; tot += v; if (q < qr) pre += v; }
            unsigned kep[8];
            bf16_t qraw[16], kraw[16];
#pragma unroll
            for (int t = 0; t < 16; ++t) {
                const int tk = qr * 16 + t; const int tkc = tk < L ? tk : 0;
                qraw[t] = PROJ[(size_t)(row0 + tkc) * NIN + gc]; kraw[t] = PROJ[(size_t)(row0 + tkc) * NIN + 512 + gc];
            }
#pragma unroll
            for (int t = 0; t < 16; t += 2) {
                float kev[2];
#pragma unroll
                for (int u = 0; u < 2; ++u) {
                    const int tk = qr * 16 + t + u; const float cm = cum[t + u] + pre;
                    float q = 0.f, k = 0.f;
                    if (tk < L) { q = bf2f(qraw[t + u]); k = bf2f(kraw[t + u]); }
                    const float qd = q * 0.08838834764831845f * __expf(cm);
                    const bf16_t qdb = f2bf(qd);
                    QD[tk * 136 + col] = qdb; KD[tk * 136 + col] = f2bf(k * __expf(-cm));
                    kev[u] = k * __expf(tot - cm);
                    if (tk < L) PROJ[(size_t)(row0 + tk) * NIN + gc] = qdb;
                }
                kep[t >> 1] = cvt_pk_bf16(kev[0], kev[1]);
            }
            *(u32x4*)(KE + col * 72 + qr * 16) = (u32x4){kep[0], kep[1], kep[2], kep[3]};
            *(u32x4*)(KE + col * 72 + qr * 16 + 8) = (u32x4){kep[4], kep[5], kep[6], kep[7]};
            if (qr == 0) DEC[((size_t)ch * 4 + h) * 128 + col] = __expf(tot);
        }
        __syncthreads();
        {
            for (int e8 = tid; e8 < 128 * L / 8; e8 += 512) {
                const int e = e8 * 8, d = e / L, tk = e % L;
                const u32x4 v = *(const u32x4*)(KE + d * 72 + tk);
                *(u32x4*)(PROJ + (size_t)(row0 + (e >> 7)) * NIN + 512 + h * 128 + (e & 127)) = v;
            }
            for (int e8 = tid; e8 < 256 * L / 8; e8 += 512) {
                const int e = e8 * 8, d = e / L, tk = e % L;
                const u32x4 v = *(const u32x4*)(VT + d * 72 + tk);
                *(u32x4*)(PROJ + (size_t)(row0 + (e >> 8)) * NIN + 1024 + h * 256 + (e & 255)) = v;
            }
        }
        {
            const int mt = wid >> 1;
#pragma unroll
            for (int nn = 0; nn < 2; ++nn) {
                const int nt = (wid & 1) * 2 + nn;
                f32x4 acc = (f32x4){0.f, 0.f, 0.f, 0.f};
                if (nt <= mt) {
#pragma unroll
                    for (int ks = 0; ks < 4; ++ks) {
                        const bf16x8 a = *(const bf16x8*)(QD + (mt * 16 + fr) * 136 + ks * 32 + fq * 8);
                        const bf16x8 bb = *(const bf16x8*)(KD + (nt * 16 + fr) * 136 + ks * 32 + fq * 8);
                        acc = __builtin_amdgcn_mfma_f32_16x16x32_bf16(bb, a, acc, 0, 0, 0);
                    }
                }
                const int t = mt * 16 + fr, s0 = nt * 16 + 4 * fq;
#pragma unroll
                for (int j = 0; j < 4; ++j) if (s0 + j > t) acc[j] = 0.f;
                *(u32x2*)(SC + t * 72 + s0) = pack4(acc);
            }
        }
        __syncthreads();
        {
#pragma unroll
            for (int nn = 0; nn < 2; ++nn) {
                const int dv0 = wid * 32 + nn * 16;
                bf16x8 bv[2];
#pragma unroll
                for (int ks = 0; ks < 2; ++ks) bv[ks] = *(const bf16x8*)(VT + (dv0 + fr) * 72 + ks * 32 + fq * 8);
                for (int mt = 0; mt < (L >> 4); ++mt) {
                    f32x4 acc = (f32x4){0.f, 0.f, 0.f, 0.f};
#pragma unroll
                    for (int ks = 0; ks < 2; ++ks) {
                        const bf16x8 a = *(const bf16x8*)(SC + (mt * 16 + fr) * 72 + ks * 32 + fq * 8);
                        acc = __builtin_amdgcn_mfma_f32_16x16x32_bf16(bv[ks], a, acc, 0, 0, 0);
                    }
                    *(u32x2*)(OB + (size_t)(row0 + mt * 16 + fr) * D + h * 256 + dv0 + 4 * fq) = pack4(acc);
                }
            }
        }
    }
}

__device__ void phase_gla_inter(const Ctx& p, unsigned char* lds, int i, const int pass) {
    const bf16_t* PROJ = (const bf16_t*)(p.ws + WS_BIG);
    bf16_t* OB = (bf16_t*)(p.ws + WS_H);
    const float* DEC = (const float*)(p.ws + WS_DEC);
    const int tid = p.tid, wid = tid >> 6, lane = tid & 63, fr = lane & 15, fq = lane >> 4;
    constexpr int BUFB = 17408 + 18432 + 512;
    f32x4* GZ = (f32x4*)(p.ws + WS_GZ); float* GP = (float*)(p.ws + WS_GP);
    const int nitem = pass == 0 ? 240 + 64 : 256;
    for (int item = p.bid; item < nitem; item += p.nb) {
        int seq, h, half, seg = 0; bool with_o = true, to_z = false;
        if (pass == 0 && item >= 240) { const int j = item - 240; seq = 2 + (j >> 3); h = (j >> 1) & 3; half = j & 1; }
        else if (pass == 0) { seg = item % 15; const int j = item / 15; seq = j >> 3; h = (j >> 1) & 3; half = j & 1; with_o = false; to_z = true; }
        else { seg = item & 15; const int j = item >> 4; seq = j >> 3; h = (j >> 1) & 3; half = j & 1; }
        const int smp = seq >= 2, b = smp ? seq - 2 : seq, L = smp ? 32 : 64, nch = smp ? 1 : 16, ch0 = smp ? 512 + b : b * 256 + seg * 16;
        const int dv0 = half * 128 + wid * 16;
        const float* s_init = smp ? PAR(5) + ((size_t)(i * 8 + b) * 4 + h) * 32768 : nullptr;
        float* s_out = p.out + (smp ? O_SGLA + ((size_t)(i * 8 + b) * 4 + h) * 32768 : O_PGLA + ((size_t)(i * 2 + b) * 4 + h) * 32768);
        f32x4 S[8], Pacc[8];
#pragma unroll
        for (int kt = 0; kt < 8; ++kt) { S[kt] = (f32x4){0.f, 0.f, 0.f, 0.f}; Pacc[kt] = (f32x4){1.f, 1.f, 1.f, 1.f}; }
        if (s_init) {
#pragma unroll
            for (int kt = 0; kt < 8; ++kt)
#pragma unroll
                for (int j = 0; j < 4; ++j) S[kt][j] = s_init[(size_t)(kt * 16 + 4 * fq + j) * 256 + dv0 + fr];
        } else if (pass == 1) {
            for (int sj = 0; sj < seg; ++sj) {
                const f32x4* zp = GZ + ((((size_t)((seq * 4 + h) * 2 + half) * 15 + sj) * 8 + wid) * 8) * 64 + lane;
                const float* pp = GP + ((size_t)(seq * 4 + h) * 15 + sj) * 128 + 4 * fq;
#pragma unroll
                for (int kt = 0; kt < 8; ++kt) S[kt] = S[kt] * *(const f32x4*)(pp + kt * 16) + zp[kt * 64];
            }
        }
        __syncthreads();
#define GLA_BAR() do { asm volatile("s_waitcnt lgkmcnt(0)" ::: "memory"); __builtin_amdgcn_s_barrier(); asm volatile("" ::: "memory"); } while (0)
        u32x4 gq[2][2], gk[2][2]; f32x4 gd[2]; bf16x8 gv[2]; u32x2 go[4];
        const int r_ = tid >> 3, part_ = tid & 7;
#define GLA_LOAD_QK(c, SET) do { int row0_, LL_; chunk_info(ch0 + (c), row0_, LL_); \
            if (r_ < L) { const bf16_t* q_ = PROJ + (size_t)(row0_ + r_) * NIN + h * 128 + part_ * 16; gq[SET][0] = *(const u32x4*)q_; gq[SET][1] = *(const u32x4*)(q_ + 8); \
                          const bf16_t* k_ = q_ + 512; gk[SET][0] = *(const u32x4*)k_; gk[SET][1] = *(const u32x4*)(k_ + 8); } \
            if (tid < 32) gd[SET] = *(const f32x4*)(DEC + ((size_t)(ch0 + (c)) * 4 + h) * 128 + tid * 4); } while (0)
#define GLA_STORE_LDS(buf, SET) do { unsigned char* base_ = lds + (buf) * BUFB; bf16_t* QD_ = (bf16_t*)base_; bf16_t* KT_ = (bf16_t*)(base_ + 17408); float* DC_ = (float*)(base_ + 17408 + 18432); \
            if (r_ < L) { *(u32x4*)(QD_ + r_ * 136 + part_ * 16) = gq[SET][0]; *(u32x4*)(QD_ + r_ * 136 + part_ * 16 + 8) = gq[SET][1]; \
                          const int e_ = r_ * 128 + part_ * 16, d_ = e_ / L, tk_ = e_ % L; *(u32x4*)(KT_ + d_ * 72 + tk_) = gk[SET][0]; *(u32x4*)(KT_ + d_ * 72 + tk_ + 8) = gk[SET][1]; } \
            if (tid < 32) *(f32x4*)(DC_ + tid * 4) = gd[SET]; } while (0)
        auto load_vo = [&](int c) {
            int row0, LL; chunk_info(ch0 + c, row0, LL);
#pragma unroll
            for (int ks = 0; ks < 2; ++ks) if (ks * 32 < L) {
                const int e = (dv0 + fr) * L + ks * 32 + 8 * fq;
                gv[ks] = *(const bf16x8*)(PROJ + (size_t)(row0 + (e >> 8)) * NIN + 1024 + h * 256 + (e & 255));
            }
#pragma unroll
            for (int mt = 0; mt < 4; ++mt) if (mt * 16 < L && with_o) go[mt] = *(const u32x2*)(OB + (size_t)(row0 + mt * 16 + fr) * D + h * 256 + dv0 + 4 * fq);
        };
        auto compute = [&](int c, const bf16x8 (&cv)[2], const u32x2 (&co)[4]) {
            int row0, LL; chunk_info(ch0 + c, row0, LL);
            unsigned char* base = lds + (c & 1) * BUFB;
            const bf16_t* QD = (const bf16_t*)base; const bf16_t* KT = (const bf16_t*)(base + 17408); const float* DC = (const float*)(base + 17408 + 18432);
            bf16x8 sb[4];
#pragma unroll
            for (int ks = 0; ks < 4; ++ks) {
                const u32x2 lo = pack4(S[2 * ks]), hi = pack4(S[2 * ks + 1]);
                u32x4 w = (u32x4){lo.x, lo.y, hi.x, hi.y};
                sb[ks] = *(bf16x8*)&w;
            }
            if (with_o) {
#pragma unroll
            for (int mt = 0; mt < 4; ++mt) if (mt * 16 < L) {
                f32x4 acc = (f32x4){0.f, 0.f, 0.f, 0.f};
#pragma unroll
                for (int ks = 0; ks < 4; ++ks) {
                    const u32x2 a0 = *(const u32x2*)(QD + (mt * 16 + fr) * 136 + ks * 32 + 4 * fq);
                    const u32x2 a1 = *(const u32x2*)(QD + (mt * 16 + fr) * 136 + ks * 32 + 16 + 4 * fq);
                    u32x4 w = (u32x4){a0.x, a0.y, a1.x, a1.y};
                    acc = __builtin_amdgcn_mfma_f32_16x16x32_bf16(sb[ks], *(bf16x8*)&w, acc, 0, 0, 0);
                }
                const f32x4 o = acc + unpack4(co[mt]);
                *(u32x2*)(OB + (size_t)(row0 + mt * 16 + fr) * D + h * 256 + dv0 + 4 * fq) = pack4(o);
            }
            }
#pragma unroll
            for (int kt = 0; kt < 8; ++kt) {
                const f32x4 dc = *(const f32x4*)(DC + kt * 16 + 4 * fq);
                S[kt] *= dc; Pacc[kt] *= dc;
#pragma unroll
                for (int ks = 0; ks < 2; ++ks) if (ks * 32 < L) {
                    const bf16x8 kb = *(const bf16x8*)(KT + (kt * 16 + fr) * 72 + ks * 32 + 8 * fq);
                    S[kt] = __builtin_amdgcn_mfma_f32_16x16x32_bf16(kb, cv[ks], S[kt], 0, 0, 0);
                }
            }
        };
        GLA_LOAD_QK(0, 0); load_vo(0);
        if (nch > 1) GLA_LOAD_QK(1, 1);
        GLA_STORE_LDS(0, 0);
        GLA_BAR();
        for (int c = 0; c < nch; c += 2) {
            {
                bf16x8 cv[2] = {gv[0], gv[1]}; u32x2 co[4] = {go[0], go[1], go[2], go[3]};
                if (c + 1 < nch) load_vo(c + 1);
                if (c + 2 < nch) GLA_LOAD_QK(c + 2, 0);
                compute(c, cv, co);
                if (c + 1 < nch) GLA_STORE_LDS(1, 1);
                GLA_BAR();
            }
            if (c + 1 < nch) {
                bf16x8 cv[2] = {gv[0], gv[1]}; u32x2 co[4] = {go[0], go[1], go[2], go[3]};
                if (c + 2 < nch) load_vo(c + 2);
                if (c + 3 < nch) GLA_LOAD_QK(c + 3, 1);
                compute(c + 1, cv, co);
                if (c + 2 < nch) GLA_STORE_LDS(0, 0);
                GLA_BAR();
            }
        }
        __syncthreads();
#undef GLA_LOAD_QK
#undef GLA_STORE_LDS
#undef GLA_BAR
        if (to_z) {
            f32x4* zp = GZ + ((((size_t)((seq * 4 + h) * 2 + half) * 15 + seg) * 8 + wid) * 8) * 64 + lane;
#pragma unroll
            for (int kt = 0; kt < 8; ++kt) zp[kt * 64] = S[kt];
            if (half == 0 && wid == 0 && fr == 0) {
                float* pp = GP + ((size_t)(seq * 4 + h) * 15 + seg) * 128 + 4 * fq;
#pragma unroll
                for (int kt = 0; kt < 8; ++kt) *(f32x4*)(pp + kt * 16) = Pacc[kt];
            }
        } else if (smp || seg == 15) {
#pragma unroll
            for (int kt = 0; kt < 8; ++kt)
#pragma unroll
                for (int j = 0; j < 4; ++j) s_out[(size_t)(kt * 16 + 4 * fq + j) * 256 + dv0 + fr] = S[kt][j];
        }
    }
}

__device__ void phase_gla_post(const Ctx& p, int i) {
    const bf16_t* PROJ = (const bf16_t*)(p.ws + WS_BIG);
    bf16_t* YC = (bf16_t*)(p.ws + WS_H);
    const float* gn = PAR(29) + i * 256;
    const int lane = p.tid & 63, wv = (p.bid * 512 + p.tid) >> 6, nw = (p.nb * 512) >> 6;
    const f32x4 gnv = *(const f32x4*)(gn + lane * 4);
    constexpr int NB = 4;
    for (int g0 = wv; g0 < MT * 4; g0 += nw * NB) {
        u32x2 ov[NB], gv[NB]; int rw[NB], cc[NB]; bool ok[NB];
#pragma unroll
        for (int k = 0; k < NB; ++k) {
            const int g = g0 + k * nw; ok[k] = g < MT * 4; const int gc = ok[k] ? g : g0;
            rw[k] = gc >> 2; cc[k] = (gc & 3) * 256 + lane * 4;
            ov[k] = *(const u32x2*)(YC + (size_t)rw[k] * D + cc[k]); gv[k] = *(const u32x2*)(PROJ + (size_t)rw[k] * NIN + 2048 + cc[k]);
        }
        float ss[NB];
#pragma unroll
        for (int k = 0; k < NB; ++k) { const f32x4 o = unpack4(ov[k]); ss[k] = o[0] * o[0] + o[1] * o[1] + o[2] * o[2] + o[3] * o[3]; }
#pragma unroll
        for (int of = 32; of > 0; of >>= 1) {
#pragma unroll
            for (int k = 0; k < NB; ++k) ss[k] += __shfl_xor(ss[k], of);
        }
#pragma unroll
        for (int k = 0; k < NB; ++k) {
            const float rs = rsqrtf(ss[k] * (1.0f / 256.0f) + 1e-6f);
            const f32x4 o = unpack4(ov[k]), gg = unpack4(gv[k]);
            f32x4 r;
#pragma unroll
            for (int j = 0; j < 4; ++j) r[j] = o[j] * rs * gnv[j] * gg[j] * sigmoidf_(gg[j]);
            if (ok[k]) *(u32x2*)(YC + (size_t)rw[k] * D + cc[k]) = pack4(r);
        }
    }
}

__global__ void __launch_bounds__(512, 2) fwd_megakernel(Params prm) {
    extern __shared__ __attribute__((aligned(16))) unsigned char shm[];
    cg::grid_group grid = cg::this_grid();
    int ph0 = prm.ph_lo;
    const int ph_hi = prm.ph_hi;
    if (threadIdx.x == 0) { *(volatile LAS unsigned*)((LAS unsigned char*)shm + 131072) = 0u; *(volatile LAS unsigned*)((LAS unsigned char*)shm + 131072 + 4) = 0u; }
    __syncthreads();
    const XcdBarrier xb = xcd_barrier_post((unsigned*)(prm.ws + WS_BAR), (volatile LAS unsigned*)((LAS unsigned char*)shm + 131072));
    if (ph0 == 0) {
        if (PHON(0)) phase_init(prm, shm);
        if (ph_hi > 1) grid.sync();
        ph0 = 1;
    }
    for (int ph = ph0; ph < ph_hi; ++ph) {
        Ctx p; size_t zoff = 0; p.tid = threadIdx.x; p.bid = blockIdx.x; p.nb = gridDim.x;
        asm volatile("" : "+s"(zoff), "+v"(p.tid), "+s"(p.bid), "+s"(p.nb));
        p.ws = prm.ws + zoff; p.out = (float*)((unsigned char*)prm.out + zoff);
        float* X = p.out;
        bf16_t* H = (bf16_t*)(p.ws + WS_H);
        bf16_t* BIG = (bf16_t*)(p.ws + WS_BIG);
        if (ph == NPH - 1) { if (PHON(11)) phase_final_norm(p, X, PAR(30)); }
        else {
            const int L = (ph - 1) / 13, st = (ph - 1) % 13, i = L >> 1, even = (L & 1) == 0;
            if (even && st == 8) continue;
            const int sub = st >= 10 ? 1 : 0;
            switch (st) {
            case 0: case 10: if (PHON(1)) phase_norm(p, X, PAR(6) + (size_t)(L * 2 + sub) * D, H); break;
            case 3: if (PHON(1)) phase_norm(p, X, PAR(10) + (size_t)L * D, H); break;
            case 1: case 11: if (PHON(2)) {
                pg8::Gemm g{H, w_gu(p.ws, L, sub), MT, 5632, 1024}; pg8::StaticOrder S; S.init(MT, 5632, p.nb, p.bid);
                pg8::EpiSwiGLU E{BIG};
                pg8::gemm_phase((LAS unsigned char*)shm, g, S, E, p.tid);
            } break;
            case 2: case 12: case 9: if (PHON(3)) {
                pg8::Gemm g; pg8::EpiResid E;
                if (st == 9) { g = pg8::Gemm{H, w_out(p.ws, L), MP, 1024, 1024}; E = pg8::EpiResid{X, 1.0f}; }
                else { g = pg8::Gemm{BIG, w_dn(p.ws, L, sub), MP, 1024, DFF}; E = pg8::EpiResid{X, 0.5f}; }
                pg8::StaticOrder S; S.init(MP, 1024, p.nb, p.bid);
                pg8::gemm_phase((LAS unsigned char*)shm, g, S, E, p.tid);
                sample_gemm_splitk(p, shm, g.A, g.Bt, g.K, X, E.scale);
            } break;
            case 4: if (PHON(4)) {
                pg8::Gemm g{H, w_in(p.ws, L), MT, NIN, 1024}; pg8::StaticOrder S; S.init(MT, NIN, p.nb, p.bid);
                pg8::EpiProj E{BIG, (bf16_t*)(p.ws + WS_HALO)};
                pg8::gemm_phase((LAS unsigned char*)shm, g, S, E, p.tid);
            } break;
            case 5: if (even) { if (PHON(5)) phase_even_prep(p, shm, i); } else { if (PHON(8)) phase_gla_intra(p, shm, i); } break;
            case 6: case 7: if (even) { if (st == 6) { if (PHON(6)) phase_scan(p, shm, i); } else { if (PHON(7)) phase_even_post(p, i); } } else { if (PHON(9)) phase_gla_inter(p, shm, i, st - 6); } break;
            case 8: if (PHON(10)) phase_gla_post(p, i); break;
            default: break;
            }
        }
        if (ph + 1 < ph_hi) xcd_barrier(xb);
    }
}

extern "C" void kernel_launch(void* const* d_in, const int* in_sizes, int n_in, void* d_out, int out_size, void* d_ws, size_t ws_size, hipStream_t stream) {
    static int grid = 0;
    if (grid == 0) {
        bool bad = n_in != 31 || (size_t)out_size != O_END || ws_size < WS_END || in_sizes[0] != MP * D || in_sizes[1] != MS * D;
        for (int k = 0; k < NPAR && !bad; ++k) if ((size_t)in_sizes[PIDX[k]] != PSZ[k]) bad = true;
        if (bad) { fprintf(stderr, "kernel_launch: unexpected shapes\n"); grid = -1; return; }
        int dev = 0, cus = 0, per_cu = 0;
        hipGetDevice(&dev);
        hipDeviceGetAttribute(&cus, hipDeviceAttributeMultiprocessorCount, dev);
        if (hipFuncSetAttribute((const void*)fwd_megakernel, hipFuncAttributeMaxDynamicSharedMemorySize, LDS_BYTES) != hipSuccess) { fprintf(stderr, "kernel_launch: hipFuncSetAttribute failed\n"); grid = -1; return; }
        if (hipOccupancyMaxActiveBlocksPerMultiprocessor(&per_cu, (const void*)fwd_megakernel, 512, LDS_BYTES) != hipSuccess || per_cu < 1) { fprintf(stderr, "kernel_launch: occupancy query gave %d\n", per_cu); per_cu = 1; }
        (void)hipGetLastError();
        grid = cus * 1;
        if (grid > 256) grid = 256;
    }
    if (grid < 0) return;
    Params p{};
    for (int i = 0; i < 31; ++i) p.in[i] = (const float*)d_in[i];
    p.out = (float*)d_out; p.ws = (unsigned char*)d_ws;
    if (hipMemsetAsync((unsigned char*)d_ws + WS_BAR, 0, 16384, stream) != hipSuccess) { fprintf(stderr, "kernel_launch: memset of the barrier words failed\n"); return; }
    p.ph_lo = 0; p.ph_hi = NPH;
    void* args[] = {&p};
    hipError_t e = hipLaunchCooperativeKernel((const void*)fwd_megakernel, dim3(grid), dim3(512), args, LDS_BYTES, stream);
    if (e != hipSuccess) fprintf(stderr, "cooperative launch failed: %s (grid %d)\n", hipGetErrorString(e), grid);
}
```

```cpp
#include <hip/hip_runtime.h>
#include <hip/hip_cooperative_groups.h>
#include <cstdio>
namespace cg = cooperative_groups;

#ifndef PH_MASK
#define PH_MASK 0xFFFF
#endif
#define PHON(b) ((PH_MASK>>(b))&1)

typedef unsigned short bf16_t;
typedef short bf16x8 __attribute__((ext_vector_type(8)));
typedef float f32x4 __attribute__((ext_vector_type(4)));
typedef float f32x2 __attribute__((ext_vector_type(2)));
typedef unsigned u32x4 __attribute__((ext_vector_type(4)));
typedef unsigned u32x2 __attribute__((ext_vector_type(2)));
#define LAS __attribute__((address_space(3)))

constexpr int MP = 32768, MS = 256, MT = MP + MS;
constexpr int D = 1024, DFF = 2816, NIN = 3328;
constexpr int SEQ = 16384, DSEQ = 32;
constexpr int NPH = 2 + 4 * 13;

constexpr size_t O_Y = 0;
constexpr size_t O_PSHIFT = (size_t)MT * D;
constexpr size_t O_PWKV = O_PSHIFT + 2 * 2 * 1792;
constexpr size_t O_PCONV = O_PWKV + 2 * 2 * 8 * 4096;
constexpr size_t O_PGLA = O_PCONV + 2 * 2 * 2 * 512;
constexpr size_t O_SSHIFT = O_PGLA + (size_t)2 * 2 * 4 * 32768;
constexpr size_t O_SWKV = O_SSHIFT + 2 * 8 * 1792;
constexpr size_t O_SCONV = O_SWKV + (size_t)2 * 8 * 8 * 4096;
constexpr size_t O_SGLA = O_SCONV + 2 * 8 * 2 * 512;
constexpr size_t O_END = O_SGLA + (size_t)2 * 8 * 4 * 32768;

constexpr size_t GU_E = (size_t)5632 * 1024, DN_E = (size_t)1024 * 2816, IN_E = (size_t)3328 * 1024, OUT_E = (size_t)1024 * 1024;
constexpr size_t WL_E = 2 * (GU_E + DN_E) + IN_E + OUT_E;
constexpr size_t WS_WB = 0;
constexpr size_t WS_SMALL = WS_WB + 4 * WL_E * 2;
constexpr size_t SMALL_E = 512 * 64 * 2 + 512 * 128;
constexpr size_t WS_H = WS_SMALL + 2 * SMALL_E * 2;
constexpr size_t WS_BIG = WS_H + (size_t)MT * 1024 * 2;
constexpr size_t WS_HALO = WS_BIG + (size_t)MT * NIN * 2;
constexpr size_t WS_SCAL = WS_HALO + (size_t)(MT / 64) * 2 * NIN * 2;
constexpr size_t WS_DEC = WS_SCAL + (size_t)MT * 8 * 4 * 4;
constexpr size_t WS_PAR = WS_DEC + (size_t)520 * 4 * 128 * 4;
constexpr int NPAR = 19;
constexpr int PIDX[NPAR] = {2, 3, 4, 5, 6, 10, 13, 14, 16, 19, 20, 21, 22, 23, 24, 27, 28, 29, 30};
constexpr size_t PSZ[NPAR] = {28672, 524288, 16384, 2097152, 8192, 4096, 3584, 1024, 1024, 1024, 1024, 1024, 1024, 1024, 3072, 16384, 1024, 512, 1024};
constexpr size_t par_off(int idx) { size_t o = 0; for (int k = 0; k < NPAR; ++k) { if (PIDX[k] == idx) return o; o += PSZ[k]; } return o; }
constexpr size_t WS_GZ = WS_PAR + par_off(-1) * 4;
constexpr size_t WS_GP = WS_GZ + (size_t)2 * 4 * 2 * 15 * 65536;
constexpr size_t WS_BAR = WS_GP + (size_t)2 * 4 * 15 * 128 * 4;
constexpr size_t WS_SSP = WS_BAR + 16384;
constexpr size_t WS_RSTD = WS_SSP + (size_t)MT * 32 * 4;
constexpr size_t WS_END = WS_RSTD + (size_t)MT * 4;
#define PAR(idx) ((const float*)(p.ws + WS_PAR) + par_off(idx))

constexpr int LDS_BYTES = 131072 + 64;

struct Params {
    const float* in[31];
    float* out;
    unsigned char* ws;
    int ph_lo, ph_hi;
};

struct Ctx { unsigned char* ws; float* out; int tid, bid, nb; };

typedef __bf16 bf16x2_t __attribute__((ext_vector_type(2)));
__device__ __forceinline__ unsigned cvt_pk_bf16(float lo, float hi) { f32x2 v = {lo, hi}; bf16x2_t r = __builtin_convertvector(v, bf16x2_t); return __builtin_bit_cast(unsigned, r); }
__device__ __forceinline__ bf16_t f2bf(float x) { return (bf16_t)(cvt_pk_bf16(x, 0.f) & 0xffffu); }
__device__ __forceinline__ float bf2f(bf16_t b) { return __uint_as_float(((unsigned)b) << 16); }
__device__ __forceinline__ float bflo(unsigned u) { return __uint_as_float(u << 16); }
__device__ __forceinline__ float bfhi(unsigned u) { return __uint_as_float(u & 0xffff0000u); }
__device__ __forceinline__ f32x4 unpack4(u32x2 u) { return (f32x4){bflo(u.x), bfhi(u.x), bflo(u.y), bfhi(u.y)}; }
__device__ __forceinline__ u32x2 pack4(f32x4 v) { u32x2 r; r.x = cvt_pk_bf16(v[0], v[1]); r.y = cvt_pk_bf16(v[2], v[3]); return r; }
__device__ __forceinline__ float sigmoidf_(float x) { return __builtin_amdgcn_rcpf(1.0f + __expf(-x)); }
__device__ __forceinline__ float wave_sum(float v) {
#pragma unroll
    for (int o = 32; o > 0; o >>= 1) v += __shfl_xor(v, o);
    return v;
}
template <int CTRL, int RM = 0xf, int BM = 0xf> __device__ __forceinline__ float dppf(float x) { return __int_as_float(__builtin_amdgcn_update_dpp(0, __float_as_int(x), CTRL, RM, BM, true)); }

#define XB_TMO      128
#define XB_XCNT(j)  (256  + 64 * (j))
#define XB_XSUB(j)  (1280 + 64 * (j))
#define XB_XGEN(j)  (2304 + 64 * (j))
#define XB_TOP      3328
#define XB_TOPGEN   3392
#define XCD_BAR_WORDS 3456
#define XB_SPIN_CAP (1u << 18)
__device__ __forceinline__ unsigned xb_ld(unsigned* p)              { return __hip_atomic_load(p, __ATOMIC_RELAXED, __HIP_MEMORY_SCOPE_AGENT); }
__device__ __forceinline__ unsigned xb_add(unsigned* p, unsigned v) { return __hip_atomic_fetch_add(p, v, __ATOMIC_RELAXED, __HIP_MEMORY_SCOPE_AGENT); }
__device__ __forceinline__ unsigned xb_xcc_id() { return (unsigned)__builtin_amdgcn_s_getreg((3 << 11) | 20) & 0xFu; }
#define XB_SPIN(cond, bar) do { unsigned _sp = 0; while (cond) { __builtin_amdgcn_s_sleep(1); \
    if ((++_sp & 255u) == 0u) { if (xb_ld(&(bar)[XB_TMO])) break; if (_sp > XB_SPIN_CAP) { atomicAdd(&(bar)[XB_TMO], 1u); break; } } } } while (0)
struct XcdBarrier { unsigned* bar; unsigned x; volatile LAS unsigned* st; };
__device__ __forceinline__ XcdBarrier xcd_barrier_post(unsigned* bar, volatile LAS unsigned* st) {
    XcdBarrier b; b.bar = bar; b.x = xb_xcc_id(); b.st = st;
    if (threadIdx.x == 0) (void)xb_add(&bar[XB_XCNT(b.x)], 1u);
    return b;
}
__device__ __forceinline__ void xcd_barrier_complete(unsigned* bar, unsigned x, unsigned& nloc, unsigned& nx) {
    const unsigned G = gridDim.x * gridDim.y * gridDim.z;
    unsigned sum, cnt, mine, sp = 0u;
    for (;;) {
        sum = 0u; cnt = 0u; mine = 0u;
#pragma unroll
        for (unsigned j = 0; j < 16; ++j) { const unsigned c = xb_ld(&bar[XB_XCNT(j)]); sum += c; cnt += (c > 0u) ? 1u : 0u; mine = (j == x) ? c : mine; }
        if (sum == G) break;
        __builtin_amdgcn_s_sleep(1);
        if ((++sp & 255u) == 0u) { if (xb_ld(&bar[XB_TMO])) break; if (sp > XB_SPIN_CAP) { atomicAdd(&bar[XB_TMO], 1u); break; } }
    }
    nloc = mine > 0u ? mine : 1u; nx = cnt > 0u ? cnt : 1u;
}
__device__ __forceinline__ void xcd_barrier(const XcdBarrier& b) {
    asm volatile("s_waitcnt vmcnt(0)" ::: "memory");
    __syncthreads();
    if (threadIdx.x == 0) {
        unsigned* bar = b.bar;
        __builtin_amdgcn_s_waitcnt(0);
        unsigned nloc = b.st[0], nx = b.st[1];
        if (nloc == 0u) { xcd_barrier_complete(bar, b.x, nloc, nx); b.st[0] = nloc; b.st[1] = nx; }
        const unsigned old = xb_add(&bar[XB_XSUB(b.x)], 1u);
        const unsigned gen = old / nloc;
        if (old + 1u == (gen + 1u) * nloc) {
            __builtin_amdgcn_fence(__ATOMIC_RELEASE, "agent");
            asm volatile("s_waitcnt vmcnt(0)" ::: "memory");
            const unsigned og = xb_add(&bar[XB_TOP], 1u);
            const unsigned tg = og / nx;
            if (og + 1u == (tg + 1u) * nx) xb_add(&bar[XB_TOPGEN], 1u);
            else XB_SPIN(xb_ld(&bar[XB_TOPGEN]) == tg, bar);
            __builtin_amdgcn_fence(__ATOMIC_ACQUIRE, "agent");
            xb_add(&bar[XB_XGEN(b.x)], 1u);
            asm volatile("s_waitcnt vmcnt(0)" ::: "memory");
        } else {
            XB_SPIN(xb_ld(&bar[XB_XGEN(b.x)]) == gen, bar);
            __builtin_amdgcn_fence(__ATOMIC_ACQUIRE, "agent");
            asm volatile("s_waitcnt vmcnt(0)" ::: "memory");
        }
    }
    __syncthreads();
}

namespace pg8 {
constexpr int BM = 256, BK = 64, HALF = 128, HTB = HALF * BK * 2, STAGE_BYTES = 8 * HTB, NXCD = 8, WGM = 8;
__device__ __forceinline__ int lds_byte(int r, int c) { const int st = (r >> 4) * 2 + (c >> 5), rr = r & 15, cc = c & 31, ob = rr * 64 + cc * 2; return st * 1024 + (ob ^ (((ob >> 9) & 1) << 5)); }
__device__ __forceinline__ void stage_rc(int b, int& R, int& C) { const int st = b / 1024, sb = b % 1024, swz = sb ^ (((sb >> 9) & 1) << 5); R = (st >> 1) * 16 + swz / 64; C = (st & 1) * 32 + (swz % 64) / 2; }
__device__ __forceinline__ int perm32(int rho) { const int n = rho >> 4, i = rho & 15; return 8 * (i >> 2) + 4 * n + (i & 3); }
struct Unit { int pm, pn; };
struct Gemm { const bf16_t* A; const bf16_t* Bt; int M, N, K; };
struct StaticOrder {
    int nM, nN, nwg, G, c;
    __device__ void init(int M, int N, int G_, int c_) { nM = M / BM; nN = N / BM; nwg = nM * nN; G = G_; c = c_; }
    __device__ bool next(int i, Unit& u) const {
        const long L = (long)i * G + c; if (L >= nwg) return false;
        int wgid = (int)L; { const int q = nwg / NXCD, r = nwg % NXCD, xcd = wgid % NXCD, off = wgid / NXCD; wgid = (xcd < r ? xcd * (q + 1) : r * (q + 1) + (xcd - r) * q) + off; }
        const int nig = WGM * nN, gid = wgid / nig, fm = gid * WGM, gsz = (nM - fm) < WGM ? (nM - fm) : WGM;
        u.pm = fm + ((wgid % nig) % gsz); u.pn = (wgid % nig) / gsz; return true;
    }
};

template <class Epi>
__device__ __forceinline__ void gemm_phase(LAS unsigned char* lds, const Gemm g, const StaticOrder& S, const Epi& E, const int tid) {
    const int wid = __builtin_amdgcn_readfirstlane(tid >> 6), lane = tid & 63, wr = wid >> 2, wc = wid & 3, fr = lane & 15, fq = lane >> 4;
    const int K = g.K, nt = K / BK;
    unsigned voffA[2], voffB[2];
#pragma unroll
    for (int i = 0; i < 2; ++i) { int R, C; stage_rc(tid * 16 + i * 8192, R, C); const int Rb = Epi::PERM ? ((R & ~31) + perm32(R & 31)) : R;
        voffA[i] = (unsigned)(R * K + C) * 2u; voffB[i] = (unsigned)(Rb * K + C) * 2u; }
    const size_t kstep = (size_t)(BK * 2);
    const size_t hstep = (size_t)HALF * K * 2;
    const size_t tstep = 2 * hstep;
    const unsigned ldsw = (unsigned)wid * 1024u;
    const int aoff = lds_byte(wr * 64 + fr, fq * 8), boff = lds_byte(wc * 32 + fr, fq * 8);
#define PG8_SA(b, h) (((b) * 2 + (h)) * HTB)
#define PG8_SB(b, h) ((4 + (b) * 2 + (h)) * HTB)
#define PG8_STAGE(bufoff, gbase, voff) do { _Pragma("unroll") for (int _i = 0; _i < 2; ++_i) \
        __builtin_amdgcn_global_load_lds((const unsigned*)((const char*)(gbase) + (voff)[_i]), (LAS unsigned*)(lds + (bufoff) + ldsw + _i * 8192), 16, 0, 0); } while (0)
#define PG8_LDA(dst, b, h) do { _Pragma("unroll") for (int m = 0; m < 4; ++m) _Pragma("unroll") for (int k = 0; k < 2; ++k) dst[m][k] = *(const LAS bf16x8*)(lds + PG8_SA(b, h) + aoff + m * 2048 + k * 1024); } while (0)
#define PG8_LDB(dst, b, h) do { _Pragma("unroll") for (int n = 0; n < 2; ++n) _Pragma("unroll") for (int k = 0; k < 2; ++k) dst[n][k] = *(const LAS bf16x8*)(lds + PG8_SB(b, h) + boff + n * 2048 + k * 1024); } while (0)
#define PG8_MMA(ai, bj, At, Bt) do { __builtin_amdgcn_s_setprio(1); _Pragma("unroll") for (int m = 0; m < 4; ++m) _Pragma("unroll") for (int n = 0; n < 2; ++n) _Pragma("unroll") for (int k = 0; k < 2; ++k) \
        acc[ai][bj][m][n] = __builtin_amdgcn_mfma_f32_16x16x32_bf16(Bt[n][k], At[m][k], acc[ai][bj][m][n], 0, 0, 0); __builtin_amdgcn_s_setprio(0); } while (0)
#define PG8_WAIT_V(n) asm volatile("s_waitcnt vmcnt(" #n ")" ::: "memory")
#define PG8_WAIT_L(n) asm volatile("s_waitcnt lgkmcnt(" #n ")" ::: "memory")
#define PG8_BAR __builtin_amdgcn_s_barrier()
#define PG8_SCHED __builtin_amdgcn_sched_barrier(0)
    Unit cur, nxt; int ui = 0;
    if (!S.next(0, cur)) return;
    f32x4 acc[2][2][4][2];
#pragma unroll
    for (int a = 0; a < 2; ++a)
#pragma unroll
        for (int b = 0; b < 2; ++b)
#pragma unroll
            for (int m = 0; m < 4; ++m)
#pragma unroll
                for (int n = 0; n < 2; ++n) acc[a][b][m][n] = (f32x4){0.f, 0.f, 0.f, 0.f};
    bf16x8 At[4][2], B0[2][2], B1[2][2];
    const char* cA = (const char*)g.A + (size_t)cur.pm * tstep; const char* cB = (const char*)g.Bt + (size_t)cur.pn * tstep;
    PG8_STAGE(PG8_SB(0, 0), cB, voffB); PG8_STAGE(PG8_SA(0, 0), cA, voffA); PG8_STAGE(PG8_SB(0, 1), cB + hstep, voffB); PG8_STAGE(PG8_SA(0, 1), cA + hstep, voffA);
    if (wr == 1) PG8_BAR;
    PG8_WAIT_V(4); PG8_BAR;
    PG8_STAGE(PG8_SB(1, 0), cB + kstep, voffB); PG8_STAGE(PG8_SA(1, 0), cA + kstep, voffA); PG8_STAGE(PG8_SB(1, 1), cB + hstep + kstep, voffB);
    PG8_WAIT_V(6); PG8_BAR;
    for (;;) {
        const bool has_next = S.next(ui + 1, nxt);
        const char* nA = has_next ? (const char*)g.A + (size_t)nxt.pm * tstep : cA; const char* nB = has_next ? (const char*)g.Bt + (size_t)nxt.pn * tstep : cB;
        for (int t = 0; t < nt; t += 2) {
            const bool last = (t == nt - 2);
            const char* a1 = cA + (size_t)(t + 1) * kstep;
            const char* a2 = last ? nA : cA + (size_t)(t + 2) * kstep; const char* b2 = last ? nB : cB + (size_t)(t + 2) * kstep;
            const char* a3 = a2 + kstep; const char* b3 = b2 + kstep;
            PG8_LDB(B0, 0, 0); PG8_SCHED; PG8_LDA(At, 0, 0); PG8_STAGE(PG8_SA(1, 1), a1 + hstep, voffA);
            PG8_WAIT_L(8); PG8_BAR; PG8_WAIT_L(0); PG8_MMA(0, 0, At, B0); PG8_BAR; PG8_SCHED;
            PG8_LDB(B1, 0, 1); PG8_STAGE(PG8_SB(0, 0), b2, voffB);
            PG8_BAR; PG8_WAIT_L(0); PG8_MMA(0, 1, At, B1); PG8_BAR;
            PG8_LDA(At, 0, 1); PG8_STAGE(PG8_SA(0, 0), a2, voffA);
            PG8_BAR; PG8_WAIT_L(0); PG8_MMA(1, 0, At, B0); PG8_BAR; PG8_SCHED;
            PG8_STAGE(PG8_SB(0, 1), b2 + hstep, voffB);
            PG8_WAIT_V(6); PG8_BAR; PG8_MMA(1, 1, At, B1); PG8_BAR;
            PG8_LDB(B0, 1, 0); PG8_SCHED; PG8_LDA(At, 1, 0); PG8_STAGE(PG8_SA(0, 1), a2 + hstep, voffA);
            PG8_WAIT_L(8); PG8_BAR; PG8_WAIT_L(0); PG8_MMA(0, 0, At, B0); PG8_BAR; PG8_SCHED;
            PG8_LDB(B1, 1, 1); PG8_STAGE(PG8_SB(1, 0), b3, voffB);
            PG8_BAR; PG8_WAIT_L(0); PG8_MMA(0, 1, At, B1); PG8_BAR;
            PG8_LDA(At, 1, 1); PG8_STAGE(PG8_SA(1, 0), a3, voffA);
            PG8_BAR; PG8_WAIT_L(0); PG8_MMA(1, 0, At, B0); PG8_BAR; PG8_SCHED;
            PG8_STAGE(PG8_SB(1, 1), b3 + hstep, voffB);
            PG8_WAIT_V(6); PG8_BAR; PG8_MMA(1, 1, At, B1); PG8_BAR;
        }
        E(acc, cur, wr, wc, fr, fq);
        if (!has_next) break;
#pragma unroll
        for (int a = 0; a < 2; ++a)
#pragma unroll
            for (int b = 0; b < 2; ++b)
#pragma unroll
                for (int m = 0; m < 4; ++m)
#pragma unroll
                    for (int n = 0; n < 2; ++n) acc[a][b][m][n] = (f32x4){0.f, 0.f, 0.f, 0.f};
        cur = nxt; cA = nA; cB = nB; ++ui;
    }
    PG8_WAIT_V(0);
    if (wr == 0) PG8_BAR;
    PG8_BAR;
#undef PG8_SA
#undef PG8_SB
#undef PG8_STAGE
#undef PG8_LDA
#undef PG8_LDB
#undef PG8_MMA
#undef PG8_WAIT_V
#undef PG8_WAIT_L
#undef PG8_BAR
#undef PG8_SCHED
}

struct EpiSwiGLU {
    static constexpr bool PERM = true;
    bf16_t* O; const float* SSP;
    __device__ __forceinline__ void operator()(const f32x4 (&acc)[2][2][4][2], const Unit& u, int wr, int wc, int fr, int fq) const {
        const int row0 = u.pm * BM + wr * 64 + fr, col0 = u.pn * 128 + wc * 32 + 8 * fq;
        float rs8[2][4];
#pragma unroll
        for (int ai = 0; ai < 2; ++ai)
#pragma unroll
            for (int m = 0; m < 4; ++m) rs8[ai][m] = SSP ? SSP[row0 + ai * HALF + m * 16] : 1.0f;
#pragma unroll
        for (int ai = 0; ai < 2; ++ai)
#pragma unroll
            for (int m = 0; m < 4; ++m) {
                const int row = row0 + ai * HALF + m * 16;
                bf16_t* rowp = O + (size_t)row * DFF + col0;
                const float rs = rs8[ai][m];
                f32x4 r0, r1;
#pragma unroll
                for (int j = 0; j < 4; ++j) {
                    const float a0 = acc[ai][0][m][0][j] * rs, a1 = acc[ai][0][m][1][j] * rs;
                    r0[j] = a0 * __builtin_amdgcn_rcpf(1.0f + __expf(-a0)) * (acc[ai][1][m][0][j] * rs);
                    r1[j] = a1 * __builtin_amdgcn_rcpf(1.0f + __expf(-a1)) * (acc[ai][1][m][1][j] * rs);
                }
                u32x4 w; w.x = cvt_pk_bf16(r0[0], r0[1]); w.y = cvt_pk_bf16(r0[2], r0[3]); w.z = cvt_pk_bf16(r1[0], r1[1]); w.w = cvt_pk_bf16(r1[2], r1[3]);
                *(u32x4*)rowp = w;
            }
    }
};
struct EpiResid {
    static constexpr bool PERM = true;
    float* X; float scale; bf16_t* XB; float* SSP;
    __device__ __forceinline__ void operator()(const f32x4 (&acc)[2][2][4][2], const Unit& u, int wr, int wc, int fr, int fq) const {
        const int row0 = u.pm * BM + wr * 64 + fr, col0 = u.pn * BM + wc * 32 + 8 * fq;
#pragma unroll
        for (int ai = 0; ai < 2; ++ai)
#pragma unroll
            for (int m = 0; m < 4; ++m) { const int row = row0 + ai * HALF + m * 16; float* rowp = X + (size_t)row * D + col0; float sq = 0.f;
#pragma unroll
                for (int bj = 0; bj < 2; ++bj) {
                    float* pp = rowp + bj * HALF;
                    const f32x4 x0 = *(const f32x4*)pp + acc[ai][bj][m][0] * scale, x1 = *(const f32x4*)(pp + 4) + acc[ai][bj][m][1] * scale;
                    *(f32x4*)pp = x0; *(f32x4*)(pp + 4) = x1;
                    if (XB) { const u32x2 w0 = pack4(x0), w1 = pack4(x1);
                        *(u32x4*)(XB + (size_t)row * D + col0 + bj * HALF) = (u32x4){w0.x, w0.y, w1.x, w1.y};
                        sq += (x0[0] * x0[0] + x0[1] * x0[1] + x0[2] * x0[2] + x0[3] * x0[3]) + (x1[0] * x1[0] + x1[1] * x1[1] + x1[2] * x1[2] + x1[3] * x1[3]); } }
                if (XB) { sq += __shfl_xor(sq, 16); sq += __shfl_xor(sq, 32); if (fq == 0) SSP[(size_t)row * 32 + u.pn * 4 + wc] = sq; } }
    }
};
struct EpiProj {
    static constexpr bool PERM = true;
    bf16_t* O; bf16_t* halo; const float* SSP;
    __device__ __forceinline__ void operator()(const f32x4 (&acc)[2][2][4][2], const Unit& u, int wr, int wc, int fr, int fq) const {
        const int row0 = u.pm * BM + wr * 64 + fr, col0 = u.pn * BM + wc * 32 + 8 * fq;
        float rs8[2][4];
#pragma unroll
        for (int ai = 0; ai < 2; ++ai)
#pragma unroll
            for (int m = 0; m < 4; ++m) rs8[ai][m] = SSP[row0 + ai * HALF + m * 16];
#pragma unroll
        for (int ai = 0; ai < 2; ++ai)
#pragma unroll
            for (int m = 0; m < 4; ++m) { const int row = row0 + ai * HALF + m * 16; bf16_t* rowp = O + (size_t)row * NIN + col0;
                const float rs = rs8[ai][m];
#pragma unroll
                for (int bj = 0; bj < 2; ++bj) { const f32x4 v0 = acc[ai][bj][m][0] * rs, v1 = acc[ai][bj][m][1] * rs;
                    u32x4 w; w.x = cvt_pk_bf16(v0[0], v0[1]); w.y = cvt_pk_bf16(v0[2], v0[3]); w.z = cvt_pk_bf16(v1[0], v1[1]); w.w = cvt_pk_bf16(v1[2], v1[3]);
                    *(u32x4*)(rowp + bj * HALF) = w;
                    if (m == 3 && fr >= 14) *(u32x4*)(halo + ((size_t)(row >> 6) * 2 + (row & 1)) * NIN + col0 + bj * HALF) = w; } }
    }
};
}

__device__ __forceinline__ void sample_gemm_splitk(const Ctx& p, unsigned char* lds, const bf16_t* A, const bf16_t* Bt, const int K, float* X, const float scale, bf16_t* XB, float* SSP) {
    float* RED = (float*)lds;
    const int tid = p.tid, wid = tid >> 6, lane = tid & 63, fr = lane & 15, fq = lane >> 4;
    const int per = K / 256;
    for (int item = p.bid; item < 512; item += p.nb) {
        const int rt = item & 15, ct = item >> 4;
        const bf16_t* ap = A + (size_t)(MP + rt * 16 + fr) * K + 8 * fq + wid * per * 32;
        const bf16_t* b0 = Bt + (size_t)(ct * 32 + fr) * K + 8 * fq + wid * per * 32; const bf16_t* b1 = b0 + (size_t)16 * K;
        f32x4 acc0 = (f32x4){0.f, 0.f, 0.f, 0.f}, acc1 = acc0;
        for (int s0 = 0; s0 < per; s0 += 6) {
            bf16x8 a[6], x0[6], x1[6];
#pragma unroll
            for (int j = 0; j < 6; ++j) if (s0 + j < per) { a[j] = *(const bf16x8*)(ap + (s0 + j) * 32); x0[j] = *(const bf16x8*)(b0 + (s0 + j) * 32); x1[j] = *(const bf16x8*)(b1 + (s0 + j) * 32); }
#pragma unroll
            for (int j = 0; j < 6; ++j) if (s0 + j < per) {
                acc0 = __builtin_amdgcn_mfma_f32_16x16x32_bf16(x0[j], a[j], acc0, 0, 0, 0);
                acc1 = __builtin_amdgcn_mfma_f32_16x16x32_bf16(x1[j], a[j], acc1, 0, 0, 0);
            }
        }
        __syncthreads();
        *(f32x4*)(RED + (wid * 64 + lane) * 8) = acc0; *(f32x4*)(RED + (wid * 64 + lane) * 8 + 4) = acc1;
        __syncthreads();
        {
            const int ln = tid & 63, part = tid >> 6;
            float sum = 0.f;
#pragma unroll
            for (int w = 0; w < 8; ++w) sum += RED[(w * 64 + ln) * 8 + part];
            const int r16 = ln & 15, cidx = (part >> 2) * 16 + 4 * (ln >> 4) + (part & 3);
            float* xp = X + (size_t)(MP + rt * 16 + r16) * D + ct * 32 + cidx;
            const float xn = *xp + scale * sum; *xp = xn;
            if (XB) {
                XB[(size_t)(MP + rt * 16 + r16) * D + ct * 32 + cidx] = f2bf(xn);
                __syncthreads();
                RED[r16 * 32 + cidx] = xn * xn;
                __syncthreads();
                if (tid < 16) { float q = 0.f;
#pragma unroll
                    for (int c2 = 0; c2 < 32; ++c2) q += RED[tid * 32 + c2];
                    SSP[(size_t)(MP + rt * 16 + tid) * 32 + ct] = q; }
            }
        }
    }
}

__device__ __forceinline__ void tconv(unsigned char* lds, const float* src, int K, int N, int Npad, bf16_t* dst, int gu_half, const float* gk = nullptr) {
    constexpr int NT = 1;
    float* tile = (float*)lds;
    const int t = threadIdx.x, tk = K >> 6, tn = Npad >> 6, ntile = tk * tn;
    for (int tl0 = blockIdx.x; tl0 < ntile; tl0 += NT * gridDim.x) {
        f32x4 v[NT][2];
#pragma unroll
        for (int u = 0; u < NT; ++u) {
            const int tl = tl0 + u * gridDim.x;
            if (tl < ntile) {
                const int k0 = (tl % tk) * 64, n0 = (tl / tk) * 64;
#pragma unroll
                for (int i = 0; i < 2; ++i) {
                    const int k = (t >> 4) + 32 * i, n4 = (t & 15) * 4;
                    v[u][i] = (f32x4){0.f, 0.f, 0.f, 0.f};
                    if (n0 + n4 < N) v[u][i] = *(const f32x4*)(src + (size_t)(k0 + k) * N + n0 + n4);
                    if (gk) v[u][i] *= gk[k0 + k];
                }
            }
        }
        __syncthreads();
#pragma unroll
        for (int u = 0; u < NT; ++u) {
            if (tl0 + u * gridDim.x < ntile) {
#pragma unroll
                for (int i = 0; i < 2; ++i) {
                    const int k = (t >> 4) + 32 * i, n4 = (t & 15) * 4; float* tp = tile + u * (64 * 65) + k * 65 + n4;
                    tp[0] = v[u][i][0]; tp[1] = v[u][i][1]; tp[2] = v[u][i][2]; tp[3] = v[u][i][3];
                }
            }
        }
        __syncthreads();
#pragma unroll
        for (int u = 0; u < NT; ++u) {
            const int tl = tl0 + u * gridDim.x;
            if (tl < ntile) {
                const int k0 = (tl % tk) * 64, n0 = (tl / tk) * 64;
                const int n = t >> 3, kc = (t & 7) * 8; const float* tp = tile + u * (64 * 65);
                u32x4 w;
                w.x = cvt_pk_bf16(tp[(kc + 0) * 65 + n], tp[(kc + 1) * 65 + n]); w.y = cvt_pk_bf16(tp[(kc + 2) * 65 + n], tp[(kc + 3) * 65 + n]);
                w.z = cvt_pk_bf16(tp[(kc + 4) * 65 + n], tp[(kc + 5) * 65 + n]); w.w = cvt_pk_bf16(tp[(kc + 6) * 65 + n], tp[(kc + 7) * 65 + n]);
                const int nn = n0 + n, drow = gu_half < 0 ? nn : (((nn >> 7) << 8) + gu_half * 128 + (nn & 127));
                *(u32x4*)(dst + (size_t)drow * K + k0 + kc) = w;
            }
        }
    }
}
__device__ __forceinline__ bf16_t* wl_base(unsigned char* ws, int L) { return (bf16_t*)(ws + WS_WB) + (size_t)L * WL_E; }
__device__ __forceinline__ bf16_t* w_gu(unsigned char* ws, int L, int sub) { return wl_base(ws, L) + (size_t)sub * (GU_E + DN_E); }
__device__ __forceinline__ bf16_t* w_dn(unsigned char* ws, int L, int sub) { return w_gu(ws, L, sub) + GU_E; }
__device__ __forceinline__ bf16_t* w_in(unsigned char* ws, int L) { return wl_base(ws, L) + 2 * (GU_E + DN_E); }
__device__ __forceinline__ bf16_t* w_out(unsigned char* ws, int L) { return w_in(ws, L) + IN_E; }
__device__ __forceinline__ bf16_t* w_small(unsigned char* ws, int i) { return (bf16_t*)(ws + WS_SMALL) + (size_t)i * SMALL_E; }

__device__ void phase_init(const Params& p, unsigned char* lds) {
    {
        const int lane = threadIdx.x & 63, wv = (blockIdx.x * 512 + threadIdx.x) >> 6, nw = (gridDim.x * 512) >> 6;
        bf16_t* H = (bf16_t*)(p.ws + WS_H); float* SSP = (float*)(p.ws + WS_SSP);
        for (int row = wv; row < MT; row += nw) {
            const f32x4* x = (const f32x4*)(row < MP ? p.in[0] + (size_t)row * D : p.in[1] + (size_t)(row - MP) * D);
            f32x4* d = (f32x4*)(p.out + (size_t)row * D);
            f32x4 v[4]; float ss = 0.f;
#pragma unroll
            for (int i = 0; i < 4; ++i) { v[i] = x[lane + 64 * i]; ss += v[i][0] * v[i][0] + v[i][1] * v[i][1] + v[i][2] * v[i][2] + v[i][3] * v[i][3]; }
            ss = wave_sum(ss);
#pragma unroll
            for (int i = 0; i < 4; ++i) { d[lane + 64 * i] = v[i]; *(u32x2*)(H + (size_t)row * D + (lane + 64 * i) * 4) = pack4(v[i]); }
            if (lane < 32) SSP[(size_t)row * 32 + lane] = lane == 0 ? ss : 0.f;
        }
    }
    {
        float* par = (float*)(p.ws + WS_PAR);
        const size_t st = (size_t)gridDim.x * blockDim.x, t0 = (size_t)blockIdx.x * blockDim.x + threadIdx.x;
#pragma unroll
        for (int k = 0; k < NPAR; ++k) {
            const f32x4* src = (const f32x4*)p.in[PIDX[k]]; f32x4* dst = (f32x4*)(par + par_off(PIDX[k]));
            for (size_t e = t0; e < PSZ[k] / 4; e += st) dst[e] = src[e];
        }
    }
    for (int L = 0; L < 4; ++L) {
        const int i = L >> 1;
        for (int sub = 0; sub < 2; ++sub) {
            const size_t o = (size_t)(L * 2 + sub) * 1024 * 2816;
            const float* gk = sub == 0 ? p.in[6] + (size_t)(L * 2) * 1024 : nullptr;
            tconv(lds, p.in[7] + o, 1024, 2816, 2816, w_gu(p.ws, L, sub), 0, gk);
            tconv(lds, p.in[8] + o, 1024, 2816, 2816, w_gu(p.ws, L, sub), 1, gk);
            tconv(lds, p.in[9] + o, 2816, 1024, 1024, w_dn(p.ws, L, sub), -1);
        }
        if ((L & 1) == 0) {
            tconv(lds, p.in[11] + (size_t)i * 1024 * 3328, 1024, 3328, 3328, w_in(p.ws, L), -1, p.in[10] + (size_t)L * 1024);
            tconv(lds, p.in[12] + (size_t)i * 1024 * 1024, 1024, 1024, 1024, w_out(p.ws, L), -1);
            tconv(lds, p.in[15] + (size_t)i * 64 * 512, 64, 512, 512, w_small(p.ws, i), -1);
            tconv(lds, p.in[17] + (size_t)i * 64 * 512, 64, 512, 512, w_small(p.ws, i) + 512 * 64, -1);
            tconv(lds, p.in[18] + (size_t)i * 128 * 512, 128, 512, 512, w_small(p.ws, i) + 2 * 512 * 64, -1);
        } else {
            tconv(lds, p.in[25] + (size_t)i * 1024 * 3088, 1024, 3088, 3328, w_in(p.ws, L), -1, p.in[10] + (size_t)L * 1024);
            tconv(lds, p.in[26] + (size_t)i * 1024 * 1024, 1024, 1024, 1024, w_out(p.ws, L), -1);
        }
    }
}

__device__ void phase_norm(const Ctx& p, const float* X, const float* g, bf16_t* H) {
    const int lane = p.tid & 63, wv = (p.bid * 512 + p.tid) >> 6, nw = (p.nb * 512) >> 6;
    f32x4 gv[4];
#pragma unroll
    for (int i = 0; i < 4; ++i) gv[i] = *(const f32x4*)(g + (lane + 64 * i) * 4);
    for (int row = wv; row < MT; row += 2 * nw) {
        const int row1 = row + nw; const bool has1 = row1 < MT;
        const f32x4* x0 = (const f32x4*)(X + (size_t)row * D); const f32x4* x1 = (const f32x4*)(X + (size_t)(has1 ? row1 : row) * D);
        f32x4 v0[4], v1[4];
#pragma unroll
        for (int i = 0; i < 4; ++i) { v0[i] = x0[lane + 64 * i]; v1[i] = x1[lane + 64 * i]; }
        float s0 = 0.f, s1 = 0.f;
#pragma unroll
        for (int i = 0; i < 4; ++i) { s0 += v0[i][0] * v0[i][0] + v0[i][1] * v0[i][1] + v0[i][2] * v0[i][2] + v0[i][3] * v0[i][3]; s1 += v1[i][0] * v1[i][0] + v1[i][1] * v1[i][1] + v1[i][2] * v1[i][2] + v1[i][3] * v1[i][3]; }
#pragma unroll
        for (int o = 32; o > 0; o >>= 1) { s0 += __shfl_xor(s0, o); s1 += __shfl_xor(s1, o); }
        const float r0 = rsqrtf(s0 * (1.0f / 1024.0f) + 1e-6f), r1 = rsqrtf(s1 * (1.0f / 1024.0f) + 1e-6f);
#pragma unroll
        for (int i = 0; i < 4; ++i) *(u32x2*)(H + (size_t)row * D + (lane + 64 * i) * 4) = pack4(v0[i] * r0 * gv[i]);
        if (has1) {
#pragma unroll
            for (int i = 0; i < 4; ++i) *(u32x2*)(H + (size_t)row1 * D + (lane + 64 * i) * 4) = pack4(v1[i] * r1 * gv[i]);
        }
    }
}
__device__ void phase_rstd(const Ctx& p) {
    const float* SSP = (const float*)(p.ws + WS_SSP); float* RS = (float*)(p.ws + WS_RSTD);
    for (int row = p.bid * 512 + p.tid; row < MT; row += p.nb * 512) {
        const f32x4* q = (const f32x4*)(SSP + (size_t)row * 32);
        const f32x4 a = (q[0] + q[1]) + (q[2] + q[3]) + ((q[4] + q[5]) + (q[6] + q[7]));
        RS[row] = rsqrtf((a[0] + a[1] + a[2] + a[3]) * (1.0f / 1024.0f) + 1e-6f);
    }
}
__device__ void phase_final_norm(const Ctx& p, float* X, const float* g) {
    const int lane = p.tid & 63, wv = (p.bid * 512 + p.tid) >> 6, nw = (p.nb * 512) >> 6;
    f32x4 gv[4];
#pragma unroll
    for (int i = 0; i < 4; ++i) gv[i] = *(const f32x4*)(g + (lane + 64 * i) * 4);
    for (int row = wv; row < MT; row += nw) {
        f32x4* x = (f32x4*)(X + (size_t)row * D);
        f32x4 v[4]; float ss = 0.f;
#pragma unroll
        for (int i = 0; i < 4; ++i) { v[i] = x[lane + 64 * i]; ss += v[i][0] * v[i][0] + v[i][1] * v[i][1] + v[i][2] * v[i][2] + v[i][3] * v[i][3]; }
        ss = wave_sum(ss);
        const float rs = rsqrtf(ss * (1.0f / 1024.0f) + 1e-6f);
#pragma unroll
        for (int i = 0; i < 4; ++i) x[lane + 64 * i] = v[i] * rs * gv[i];
    }
}

struct RowInfo { int t, b, smp, len; };
__device__ __forceinline__ RowInfo row_info(int row) {
    RowInfo r;
    if (row < MP) { r.t = row & (SEQ - 1); r.b = row >> 14; r.smp = 0; r.len = SEQ; }
    else { const int q = row - MP; r.t = q & 31; r.b = q >> 5; r.smp = 1; r.len = DSEQ; }
    return r;
}

__device__ void phase_even_prep(const Ctx& p, unsigned char* lds, int i) {
    bf16_t* PROJ = (bf16_t*)(p.ws + WS_BIG);
    const bf16_t* HALO = (const bf16_t*)(p.ws + WS_HALO);
    bf16_t* YC = (bf16_t*)(p.ws + WS_H);
    float* SCAL = (float*)(p.ws + WS_SCAL);
    const float* st_shift = PAR(2) + (size_t)i * 8 * 1792;
    const float* st_conv = PAR(4) + (size_t)i * 8 * 2 * 512;
    const float* mu = PAR(13) + (size_t)i * 1792;
    const float* cw = PAR(24) + (size_t)i * 3 * 512;
    const bf16_t* wupT = w_small(p.ws, i); const bf16_t* aupT = wupT + 512 * 64; const bf16_t* gupT = wupT + 2 * 512 * 64;
    const int tid = p.tid, wid = tid >> 6, lane = tid & 63, fr = lane & 15, fq = lane >> 4;
    float* CST = (float*)lds;
    bf16_t* AW = (bf16_t*)(lds + 16384); bf16_t* AA = AW + 64 * 72; bf16_t* AG = AA + 64 * 72;
    {
        const int c = tid;
        CST[0 * 512 + c] = mu[c]; CST[1 * 512 + c] = mu[512 + c]; CST[2 * 512 + c] = mu[1024 + c];
        CST[3 * 512 + c] = (PAR(14) + i * 512)[c]; CST[4 * 512 + c] = (PAR(16) + i * 512)[c];
        CST[5 * 512 + c] = (PAR(19) + i * 512)[c]; CST[6 * 512 + c] = (PAR(20) + i * 512)[c]; CST[7 * 512 + c] = (PAR(21) + i * 512)[c];
    }
    const int th = tid >> 8;
    for (int tile = p.bid; tile < MT / 64; tile += p.nb) {
        const int row0 = tile * 64;
        __syncthreads();
        {
            const int cp2 = (tid & 255) * 2;
            const f32x2 cw0 = *(const f32x2*)(cw + cp2), cw1 = *(const f32x2*)(cw + 512 + cp2), cw2 = *(const f32x2*)(cw + 1024 + cp2);
            const int tk0 = th * 32, rowa = row0 + tk0; const RowInfo ra = row_info(rowa);
            f32x2 u1, u2;
            if (ra.t == 0) {
                if (ra.smp) { u2 = *(const f32x2*)(st_conv + (size_t)ra.b * 1024 + cp2); u1 = *(const f32x2*)(st_conv + (size_t)ra.b * 1024 + 512 + cp2); }
                else { u1 = (f32x2){0.f, 0.f}; u2 = u1; }
            } else {
                const bf16_t* h0 = (th == 0) ? HALO + ((size_t)(tile - 1) * 2) * NIN : PROJ + (size_t)(rowa - 2) * NIN; const bf16_t* h1 = h0 + NIN;
                const unsigned a0_ = *(const unsigned*)(h0 + 2304 + cp2), b0_ = *(const unsigned*)(h0 + 2816 + cp2), a1_ = *(const unsigned*)(h1 + 2304 + cp2), b1_ = *(const unsigned*)(h1 + 2816 + cp2);
                u2 = (f32x2){bflo(a0_) * bflo(b0_), bfhi(a0_) * bfhi(b0_)}; u1 = (f32x2){bflo(a1_) * bflo(b1_), bfhi(a1_) * bfhi(b1_)};
            }
            float* oc = p.out + (ra.smp ? O_SCONV + (size_t)(i * 8 + ra.b) * 1024 : O_PCONV + (size_t)(i * 2 + ra.b) * 1024);
#pragma unroll 1
            for (int bt = 0; bt < 4; ++bt) {
                unsigned gb[8], gc[8], hb[8];
#pragma unroll
                for (int j = 0; j < 8; ++j) { const bf16_t* pr = PROJ + (size_t)(rowa + bt * 8 + j) * NIN; gb[j] = *(const unsigned*)(pr + 1792 + cp2); gc[j] = *(const unsigned*)(pr + 2304 + cp2); hb[j] = *(const unsigned*)(pr + 2816 + cp2); }
                unsigned yo[8];
#pragma unroll
                for (int j = 0; j < 8; ++j) {
                    const f32x2 u0 = (f32x2){bflo(gc[j]) * bflo(hb[j]), bfhi(gc[j]) * bfhi(hb[j])};
                    const f32x2 y = (f32x2){bflo(gb[j]), bfhi(gb[j])} * (cw0 * u2 + cw1 * u1 + cw2 * u0);
                    yo[j] = cvt_pk_bf16(y.x, y.y);
                    const int t = ra.t + bt * 8 + j;
                    if (t >= ra.len - 2) *(f32x2*)(oc + (t - (ra.len - 2)) * 512 + cp2) = u0;
                    u2 = u1; u1 = u0;
                }
#pragma unroll
                for (int j = 0; j < 8; ++j) *(unsigned*)(YC + (size_t)(rowa + bt * 8 + j) * D + 512 + cp2) = yo[j];
            }
        }
        {
            const int lcol = tid & 255, pc = 1536 + lcol; const float mu_l = mu[pc];
            const int tk0 = th * 32, rowa = row0 + tk0; const RowInfo ra = row_info(rowa);
            float prev;
            if (ra.t == 0) prev = ra.smp ? st_shift[(size_t)ra.b * 1792 + pc] : 0.f;
            else prev = (th == 0) ? bf2f(HALO[((size_t)(tile - 1) * 2 + 1) * NIN + pc]) : bf2f(PROJ[(size_t)(rowa - 1) * NIN + pc]);
            bf16_t cu[32];
#pragma unroll
            for (int j = 0; j < 32; ++j) cu[j] = PROJ[(size_t)(rowa + j) * NIN + pc];
#pragma unroll
            for (int j = 0; j < 32; ++j) {
                const int tk = tk0 + j; const float cur = bf2f(cu[j]);
                const float xs = cur + (prev - cur) * mu_l;
                if (lcol < 64) AW[tk * 72 + lcol] = f2bf(tanhf(xs));
                else if (lcol < 128) AA[tk * 72 + lcol - 64] = f2bf(xs);
                else AG[((lcol - 128) >> 6) * (64 * 72) + tk * 72 + ((lcol - 128) & 63)] = f2bf(sigmoidf_(xs));
                prev = cur;
            }
            if (ra.t + 31 == ra.len - 1) p.out[(ra.smp ? O_SSHIFT + (size_t)(i * 8 + ra.b) * 1792 : O_PSHIFT + (size_t)(i * 2 + ra.b) * 1792) + pc] = prev;
        }
        __syncthreads();
        {
            const int h = wid;
            float a_n2[4] = {0.f, 0.f, 0.f, 0.f}, a_s1[4] = {0.f, 0.f, 0.f, 0.f}, a_s2[4] = {0.f, 0.f, 0.f, 0.f}, a_sb[4] = {0.f, 0.f, 0.f, 0.f};
#pragma unroll 1
            for (int n = 0; n < 4; ++n) {
                const int c = h * 64 + n * 16 + 4 * fq;
                bf16x8 bw[2], ba[2], bg[4];
#pragma unroll
                for (int ks = 0; ks < 2; ++ks) { bw[ks] = *(const bf16x8*)(wupT + (size_t)(h * 64 + n * 16 + fr) * 64 + ks * 32 + fq * 8); ba[ks] = *(const bf16x8*)(aupT + (size_t)(h * 64 + n * 16 + fr) * 64 + ks * 32 + fq * 8); }
#pragma unroll
                for (int ks = 0; ks < 4; ++ks) bg[ks] = *(const bf16x8*)(gupT + (size_t)(h * 64 + n * 16 + fr) * 128 + ks * 32 + fq * 8);
                u32x2 rc[2][3], rq[2][3];
#pragma unroll 1
                for (int m = 3; m >= 0; --m) {
                    if (m & 1) {
#pragma unroll
                        for (int mm = 0; mm < 2; ++mm) {
                            const int tk = (m - 1 + mm) * 16 + fr, row = row0 + tk; const RowInfo ri = row_info(row);
                            const bf16_t* pr = PROJ + (size_t)row * NIN + c;
#pragma unroll
                            for (int a = 0; a < 3; ++a) rc[mm][a] = *(const u32x2*)(pr + a * 512);
                            if (ri.t == 0) {
                                if (ri.smp) { const float* pf = st_shift + (size_t)ri.b * 1792 + c;
#pragma unroll
                                    for (int a = 0; a < 3; ++a) rq[mm][a] = pack4(*(const f32x4*)(pf + a * 512)); }
                                else {
#pragma unroll
                                    for (int a = 0; a < 3; ++a) rq[mm][a] = (u32x2){0u, 0u}; }
                            } else {
                                const bf16_t* pb = ((tk == 0) ? HALO + ((size_t)(tile - 1) * 2 + 1) * NIN : PROJ + (size_t)(row - 1) * NIN) + c;
#pragma unroll
                                for (int a = 0; a < 3; ++a) rq[mm][a] = *(const u32x2*)(pb + a * 512);
                            }
                        }
                    }
                    f32x4 in_c[3], in_q[3];
#pragma unroll
                    for (int a = 0; a < 3; ++a) {
                        const bool od = (m & 1) != 0;
                        u32x2 sc, sq; sc.x = od ? rc[1][a].x : rc[0][a].x; sc.y = od ? rc[1][a].y : rc[0][a].y; sq.x = od ? rq[1][a].x : rq[0][a].x; sq.y = od ? rq[1][a].y : rq[0][a].y;
                        in_c[a] = unpack4(sc); in_q[a] = unpack4(sq);
                    }
                    const f32x4 mur = *(const f32x4*)(CST + 0 * 512 + c), muk = *(const f32x4*)(CST + 1 * 512 + c), muv = *(const f32x4*)(CST + 2 * 512 + c), w0v = *(const f32x4*)(CST + 3 * 512 + c),
                                a0v = *(const f32x4*)(CST + 4 * 512 + c), kkv = *(const f32x4*)(CST + 5 * 512 + c), kav = *(const f32x4*)(CST + 6 * 512 + c), rkv = *(const f32x4*)(CST + 7 * 512 + c);
                    f32x4 dwn = (f32x4){0.f, 0.f, 0.f, 0.f}, dan = dwn, dgn = dwn;
#pragma unroll
                    for (int ks = 0; ks < 2; ++ks) {
                        const bf16x8 aw = *(const bf16x8*)(AW + (m * 16 + fr) * 72 + ks * 32 + fq * 8);
                        const bf16x8 aa = *(const bf16x8*)(AA + (m * 16 + fr) * 72 + ks * 32 + fq * 8);
                        dwn = __builtin_amdgcn_mfma_f32_16x16x32_bf16(bw[ks], aw, dwn, 0, 0, 0);
                        dan = __builtin_amdgcn_mfma_f32_16x16x32_bf16(ba[ks], aa, dan, 0, 0, 0);
                    }
#pragma unroll
                    for (int ks = 0; ks < 4; ++ks) {
                        const bf16x8 ag = *(const bf16x8*)(AG + (ks >> 1) * (64 * 72) + (m * 16 + fr) * 72 + (ks & 1) * 32 + fq * 8);
                        dgn = __builtin_amdgcn_mfma_f32_16x16x32_bf16(bg[ks], ag, dgn, 0, 0, 0);
                    }
                    const int tk = m * 16 + fr, row = row0 + tk; const RowInfo ri = row_info(row);
                    bf16_t* pr = PROJ + (size_t)row * NIN;
                    if (ri.t == ri.len - 1) {
                        float* osh = p.out + (ri.smp ? O_SSHIFT + (size_t)(i * 8 + ri.b) * 1792 : O_PSHIFT + (size_t)(i * 2 + ri.b) * 1792);
                        *(f32x4*)(osh + c) = in_c[0]; *(f32x4*)(osh + 512 + c) = in_c[1]; *(f32x4*)(osh + 1024 + c) = in_c[2];
                    }
                    const f32x4 xr = in_c[0] + (in_q[0] - in_c[0]) * mur, xk = in_c[1] + (in_q[1] - in_c[1]) * muk, xv = in_c[2] + (in_q[2] - in_c[2]) * muv;
                    f32x4 e, a; float t_n2 = 0.f, t_s1 = 0.f, t_s2 = 0.f, t_sb = 0.f;
#pragma unroll
                    for (int j = 0; j < 4; ++j) {
                        e[j] = sigmoidf_(w0v[j] + dwn[j]) * 0.60653065971f;
                        a[j] = sigmoidf_(a0v[j] + dan[j]);
                        const float kkr = xk[j] * kkv[j], kef = xk[j] * (1.0f + (a[j] - 1.0f) * kav[j]);
                        t_n2 += kkr * kkr; t_s1 += kkr * a[j] * xr[j]; t_s2 += kef * xr[j]; t_sb += xr[j] * kef * rkv[j];
                    }
#pragma unroll
                    for (int mm = 0; mm < 4; ++mm) { const bool on = (mm == m); a_n2[mm] += on ? t_n2 : 0.f; a_s1[mm] += on ? t_s1 : 0.f; a_s2[mm] += on ? t_s2 : 0.f; a_sb[mm] += on ? t_sb : 0.f; }
                    *(u32x2*)(pr + c) = pack4(xr); *(u32x2*)(pr + 512 + c) = pack4(xk); *(u32x2*)(pr + 1024 + c) = pack4(xv);
                    *(u32x2*)(pr + 1792 + c) = pack4(e); *(u32x2*)(pr + 2304 + c) = pack4(a); *(u32x2*)(pr + 2816 + c) = pack4(dgn);
                }
            }
#pragma unroll
            for (int m = 0; m < 4; ++m) {
                float n2 = a_n2[m], s1 = a_s1[m], s2 = a_s2[m], sb = a_sb[m];
                n2 += __shfl_xor(n2, 16); n2 += __shfl_xor(n2, 32);
                s1 += __shfl_xor(s1, 16); s1 += __shfl_xor(s1, 32);
                s2 += __shfl_xor(s2, 16); s2 += __shfl_xor(s2, 32);
                sb += __shfl_xor(sb, 16); sb += __shfl_xor(sb, 32);
                if (fq == 0) { const float inv = 1.0f / fmaxf(sqrtf(n2), 1e-12f); *(f32x4*)(SCAL + ((size_t)(row0 + m * 16 + fr) * 8 + h) * 4) = (f32x4){inv, s1 * inv, s2, sb}; }
            }
        }
    }
}

__device__ __forceinline__ void scan_consume(float& s, const f32x4* Q4, const float* KE, int lane, float vv, float c1, float c2, float& yout) {
    float rec0 = 0.f, rec1 = 0.f;
    const int l15 = lane & 15;
    f32x4 qa[8]; float ka[8];
#pragma unroll
    for (int u = 0; u < 8; ++u) { qa[u] = Q4[u * 64 + lane]; ka[u] = KE[u * 64 + lane]; }
#pragma unroll
    for (int g = 0; g < 4; ++g) {
        f32x4 qb[8]; float kb[8];
        if (g + 1 < 4) {
#pragma unroll
            for (int u = 0; u < 8; ++u) { qb[u] = Q4[((g + 1) * 8 + u) * 64 + lane]; kb[u] = KE[((g + 1) * 8 + u) * 64 + lane]; }
        }
#pragma unroll
        for (int u = 0; u < 8; ++u) {
            const int tt = g * 8 + u;
            const f32x4 q = qa[u];
            const float p1 = s * q[0], p2 = s * q[1];
            auto r = __builtin_amdgcn_permlane32_swap(__float_as_uint(p1), __float_as_uint(p2), false, false);
            float x = __uint_as_float(r[0]) + __uint_as_float(r[1]);
            x += dppf<0xB1>(x); x += dppf<0x4E>(x); x += dppf<0x141>(x); x += dppf<0x140>(x);
            const float sa0 = __int_as_float(__builtin_amdgcn_readlane(__float_as_int(x), 0));
            const float sa1 = __int_as_float(__builtin_amdgcn_readlane(__float_as_int(x), 16));
            const float vt = __int_as_float(__builtin_amdgcn_readlane(__float_as_int(vv), tt));
            float sn = fmaf(s, q[2], vt * ka[u]);
            sn = fmaf(-sa0, q[3], sn); s = fmaf(-sa1, q[3], sn);
            if (tt < 16) rec0 = (l15 == (tt & 15)) ? x : rec0; else rec1 = (l15 == (tt & 15)) ? x : rec1;
        }
        if (g + 1 < 4) {
#pragma unroll
            for (int u = 0; u < 8; ++u) { qa[u] = qb[u]; ka[u] = kb[u]; }
        }
        __builtin_amdgcn_sched_barrier(0);
    }
    const float a0 = __shfl(rec0, l15), a1 = __shfl(rec0, 16 + l15), b0 = __shfl(rec0, 32 + l15), b1 = __shfl(rec0, 48 + l15);
    const float a2 = __shfl(rec1, l15), a3 = __shfl(rec1, 16 + l15), b2 = __shfl(rec1, 32 + l15), b3 = __shfl(rec1, 48 + l15);
    const float sav = (lane < 16) ? a0 + a1 : a2 + a3, yav = (lane < 16) ? b0 + b1 : b2 + b3;
    yout = yav - sav * c1 + vv * c2;
}
__device__ void phase_scan(const Ctx& p, unsigned char* lds, int i) {
    const bf16_t* PROJ = (const bf16_t*)(p.ws + WS_BIG);
    bf16_t* YC = (bf16_t*)(p.ws + WS_H);
    const float* SCAL = (const float*)(p.ws + WS_SCAL);
    const float* k_k = PAR(19) + i * 512; const float* k_a = PAR(20) + i * 512;
    const int tid = p.tid, wid = tid >> 6, lane = tid & 63;
    f32x4* Q4 = (f32x4*)lds;
    float* KE = (float*)(lds + 65536);
    for (int job = p.bid; job < 512; job += p.nb) {
        int seq, h, rbase, rpw;
        if (job < 256) { seq = job >> 7; h = (job >> 4) & 7; rbase = (job & 15) * 4; rpw = 1; }
        else { const int j = job - 256; seq = 2 + (j >> 5); h = (j >> 2) & 7; rbase = (j & 3) * 16; rpw = 4; }
        const int smp = seq >= 2, b = smp ? seq - 2 : seq, row0 = smp ? MP + b * 32 : b * SEQ, len = smp ? DSEQ : SEQ, nch = len >> 5;
        const float* s_init = smp ? PAR(3) + ((size_t)(i * 8 + b) * 8 + h) * 4096 : nullptr;
        float* s_out = p.out + (smp ? O_SWKV + ((size_t)(i * 8 + b) * 8 + h) * 4096 : O_PWKV + ((size_t)(i * 2 + b) * 8 + h) * 4096);
        __syncthreads();
        if (wid >= 4) {
            const int pw = wid - 4, col = h * 64 + lane;
            const float kkc = k_k[col], kac = k_a[col];
            unsigned rxr[8], rxk[8], re[8], ra[8]; float rinv[8];
            auto load_raw = [&](int c) {
#pragma unroll
                for (int ii = 0; ii < 8; ++ii) {
                    const int row = row0 + c * 32 + pw * 8 + ii; const bf16_t* pr = PROJ + (size_t)row * NIN;
                    rxr[ii] = pr[col]; rxk[ii] = pr[512 + col]; re[ii] = pr[1792 + col]; ra[ii] = pr[2304 + col];
                    rinv[ii] = SCAL[((size_t)row * 8 + h) * 4];
                }
            };
            auto write_lds = [&](int c) {
                f32x4* q = Q4 + (c & 1) * 2048; float* ke = KE + (c & 1) * 2048;
#pragma unroll
                for (int ii = 0; ii < 8; ++ii) {
                    const int tt = pw * 8 + ii;
                    const float xr = bf2f((bf16_t)rxr[ii]), xk = bf2f((bf16_t)rxk[ii]), e = bf2f((bf16_t)re[ii]), a = bf2f((bf16_t)ra[ii]);
                    const float kk = xk * kkc * rinv[ii], w = __expf(-e);
                    q[tt * 64 + lane] = (f32x4){kk, w * xr, w, kk * a};
                    ke[tt * 64 + lane] = xk * (1.0f + (a - 1.0f) * kac);
                }
            };
            load_raw(0);
            for (int c = 0; c <= nch; ++c) {
                if (c < nch) {
                    write_lds(c);
                    if (c + 1 < nch) load_raw(c + 1);
                }
                __syncthreads();
            }
        } else if (rpw == 1) {
            __builtin_amdgcn_s_setprio(3);
            const int vrow = rbase + wid, vcol = 1024 + h * 64 + vrow;
            float s = s_init ? s_init[vrow * 64 + lane] : 0.f;
            float vv = 0.f, c1 = 0.f, c2 = 0.f;
            if (lane < 32) { const int row = row0 + lane; vv = bf2f(PROJ[(size_t)row * NIN + vcol]); const float* sc = SCAL + ((size_t)row * 8 + h) * 4; c1 = sc[1]; c2 = sc[2]; }
            __syncthreads();
            for (int c = 0; c < nch; ++c) {
                float vn = 0.f, c1n = 0.f, c2n = 0.f;
                if (c + 1 < nch && lane < 32) { const int row = row0 + (c + 1) * 32 + lane; vn = bf2f(PROJ[(size_t)row * NIN + vcol]); const float* sc = SCAL + ((size_t)row * 8 + h) * 4; c1n = sc[1]; c2n = sc[2]; }
                float y;
                scan_consume(s, Q4 + (c & 1) * 2048, KE + (c & 1) * 2048, lane, vv, c1, c2, y);
                if (lane < 32) YC[(size_t)(row0 + c * 32 + lane) * D + h * 64 + vrow] = f2bf(y);
                vv = vn; c1 = c1n; c2 = c2n;
                __syncthreads();
            }
            s_out[vrow * 64 + lane] = s;
            __builtin_amdgcn_s_setprio(0);
        } else {
            __syncthreads();
            for (int r = 0; r < 4; ++r) {
                const int vrow = rbase + wid * 4 + r, vcol = 1024 + h * 64 + vrow;
                float s = s_init[vrow * 64 + lane];
                float vv = 0.f, c1 = 0.f, c2 = 0.f;
                if (lane < 32) { const int row = row0 + lane; vv = bf2f(PROJ[(size_t)row * NIN + vcol]); const float* sc = SCAL + ((size_t)row * 8 + h) * 4; c1 = sc[1]; c2 = sc[2]; }
                float y;
                scan_consume(s, Q4, KE, lane, vv, c1, c2, y);
                if (lane < 32) YC[(size_t)(row0 + lane) * D + h * 64 + vrow] = f2bf(y);
                s_out[vrow * 64 + lane] = s;
            }
            __syncthreads();
        }
    }
}

__device__ void phase_even_post(const Ctx& p, int i) {
    const bf16_t* PROJ = (const bf16_t*)(p.ws + WS_BIG);
    bf16_t* YC = (bf16_t*)(p.ws + WS_H);
    const float* SCAL = (const float*)(p.ws + WS_SCAL);
    const float* lnw = PAR(22) + i * 512; const float* lnb = PAR(23) + i * 512;
    const int lane = p.tid & 63, wv = (p.bid * 512 + p.tid) >> 6, nw = (p.nb * 512) >> 6;
    const int l16 = lane & 15, sub = lane >> 4;
    constexpr int NB = 4;
    for (int g0 = wv * 4; g0 < MT * 8; g0 += nw * 4 * NB) {
        u32x2 yy[NB], vv[NB], gg[NB]; float cb[NB]; int rw[NB], cc[NB]; bool ok[NB];
#pragma unroll
        for (int k = 0; k < NB; ++k) {
            const int g = g0 + k * nw * 4 + sub; ok[k] = g < MT * 8; const int gc = ok[k] ? g : g0 + sub;
            rw[k] = gc >> 3; const int h = gc & 7; cc[k] = h * 64 + l16 * 4;
            yy[k] = *(const u32x2*)(YC + (size_t)rw[k] * D + cc[k]);
            vv[k] = *(const u32x2*)(PROJ + (size_t)rw[k] * NIN + 1024 + cc[k]); gg[k] = *(const u32x2*)(PROJ + (size_t)rw[k] * NIN + 2816 + cc[k]);
            cb[k] = SCAL[((size_t)rw[k] * 8 + h) * 4 + 3];
        }
        u32x2 oo[NB];
#pragma unroll
        for (int k = 0; k < NB; ++k) {
            const f32x4 y = unpack4(yy[k]);
            float sm = y[0] + y[1] + y[2] + y[3];
            sm += __shfl_xor(sm, 1); sm += __shfl_xor(sm, 2); sm += __shfl_xor(sm, 4); sm += __shfl_xor(sm, 8);
            const float mean = sm * (1.0f / 64.0f);
            const f32x4 d = y - mean;
            float vr = d[0] * d[0] + d[1] * d[1] + d[2] * d[2] + d[3] * d[3];
            vr += __shfl_xor(vr, 1); vr += __shfl_xor(vr, 2); vr += __shfl_xor(vr, 4); vr += __shfl_xor(vr, 8);
            const float rs = rsqrtf(vr * (1.0f / 64.0f) + 64e-5f);
            const f32x4 o = (d * rs * *(const f32x4*)(lnw + cc[k]) + *(const f32x4*)(lnb + cc[k]) + unpack4(vv[k]) * cb[k]) * unpack4(gg[k]);
            oo[k] = pack4(o);
        }
#pragma unroll
        for (int k = 0; k < NB; ++k) if (ok[k]) *(u32x2*)(YC + (size_t)rw[k] * D + cc[k]) = oo[k];
    }
}

__device__ __forceinline__ void chunk_info(int ch, int& row0, int& L) { if (ch < 512) { row0 = ch * 64; L = 64; } else { row0 = MP + (ch - 512) * 32; L = 32; } }
__device__ void phase_gla_intra(const Ctx& p, unsigned char* lds, int i) {
    bf16_t* PROJ = (bf16_t*)(p.ws + WS_BIG);
    bf16_t* OB = (bf16_t*)(p.ws + WS_H);
    float* DEC = (float*)(p.ws + WS_DEC);
    const float* a_up = PAR(27) + (size_t)i * 16 * 512; const float* a_b = PAR(28) + i * 512;
    const int tid = p.tid, wid = tid >> 6, lane = tid & 63, fr = lane & 15, fq = lane >> 4;
    bf16_t* QD = (bf16_t*)lds;
    bf16_t* KD = QD + 64 * 136;
    bf16_t* VT = KD + 64 * 136;
    bf16_t* SC = VT + 256 * 72;
    bf16_t* KE = SC + 64 * 72;
    float* ALO = (float*)(KE + 128 * 72);
    float* PS = ALO + 64 * 16;
    for (int item = p.bid; item < 520 * 4; item += p.nb) {
        const int ch = item >> 2, h = item & 3; int row0, L; chunk_info(ch, row0, L);
        __syncthreads();
        for (int e = tid; e < 64 * 16; e += 512) { const int tk = e >> 4, j = e & 15; ALO[e] = tk < L ? bf2f(PROJ[(size_t)(row0 + tk) * NIN + 3072 + j]) : 0.f; }
        for (int e = tid; e < 64 * 64; e += 512) {
            const int tk = e >> 6, d4 = (e & 63) * 4;
            u32x2 v = (u32x2){0u, 0u};
            if (tk < L) v = *(const u32x2*)(PROJ + (size_t)(row0 + tk) * NIN + 1024 + h * 256 + d4);
            VT[(d4 + 0) * 72 + tk] = (bf16_t)(v.x & 0xffffu); VT[(d4 + 1) * 72 + tk] = (bf16_t)(v.x >> 16);
            VT[(d4 + 2) * 72 + tk] = (bf16_t)(v.y & 0xffffu); VT[(d4 + 3) * 72 + tk] = (bf16_t)(v.y >> 16);
        }
        __syncthreads();
        {
            const int col = tid & 127, qr = tid >> 7, gc = h * 128 + col;
            float wv[16];
#pragma unroll
            for (int j = 0; j < 16; ++j) wv[j] = a_up[j * 512 + gc];
            const float bias = a_b[gc];
            float cum[16]; float run = 0.f;
#pragma unroll
            for (int t = 0; t < 16; ++t) {
                const int tk = qr * 16 + t;
                float x = bias;
#pragma unroll
                for (int j = 0; j < 16; ++j) x += ALO[tk * 16 + j] * wv[j];
                const float la = tk < L ? (fminf(x, 0.f) - __logf(1.0f + __expf(-fabsf(x)))) * (1.0f / 16.0f) : 0.f;
                run += la; cum[t] = run;
            }
            PS[qr * 128 + col] = run;
            __syncthreads();
            float pre = 0.f, tot = 0.f;
#pragma unroll
            for (int q = 0; q < 4; ++q) { const float v = PS[q * 128 + col]; tot += v; if (q < qr) pre += v; }
            unsigned kep[8];
            bf16_t qraw[16], kraw[16];
#pragma unroll
            for (int t = 0; t < 16; ++t) {
                const int tk = qr * 16 + t; const int tkc = tk < L ? tk : 0;
                qraw[t] = PROJ[(size_t)(row0 + tkc) * NIN + gc]; kraw[t] = PROJ[(size_t)(row0 + tkc) * NIN + 512 + gc];
            }
#pragma unroll
            for (int t = 0; t < 16; t += 2) {
                float kev[2];
#pragma unroll
                for (int u = 0; u < 2; ++u) {
                    const int tk = qr * 16 + t + u; const float cm = cum[t + u] + pre;
                    float q = 0.f, k = 0.f;
                    if (tk < L) { q = bf2f(qraw[t + u]); k = bf2f(kraw[t + u]); }
                    const float qd = q * 0.08838834764831845f * __expf(cm);
                    const bf16_t qdb = f2bf(qd);
                    QD[tk * 136 + col] = qdb; KD[tk * 136 + col] = f2bf(k * __expf(-cm));
                    kev[u] = k * __expf(tot - cm);
                    if (tk < L) PROJ[(size_t)(row0 + tk) * NIN + gc] = qdb;
                }
                kep[t >> 1] = cvt_pk_bf16(kev[0], kev[1]);
            }
            *(u32x4*)(KE + col * 72 + qr * 16) = (u32x4){kep[0], kep[1], kep[2], kep[3]};
            *(u32x4*)(KE + col * 72 + qr * 16 + 8) = (u32x4){kep[4], kep[5], kep[6], kep[7]};
            if (qr == 0) DEC[((size_t)ch * 4 + h) * 128 + col] = __expf(tot);
        }
        __syncthreads();
        {
            for (int e8 = tid; e8 < 128 * L / 8; e8 += 512) {
                const int e = e8 * 8, d = e / L, tk = e % L;
                const u32x4 v = *(const u32x4*)(KE + d * 72 + tk);
                *(u32x4*)(PROJ + (size_t)(row0 + (e >> 7)) * NIN + 512 + h * 128 + (e & 127)) = v;
            }
            for (int e8 = tid; e8 < 256 * L / 8; e8 += 512) {
                const int e = e8 * 8, d = e / L, tk = e % L;
                const u32x4 v = *(const u32x4*)(VT + d * 72 + tk);
                *(u32x4*)(PROJ + (size_t)(row0 + (e >> 8)) * NIN + 1024 + h * 256 + (e & 255)) = v;
            }
        }
        {
            const int mt = wid >> 1;
#pragma unroll
            for (int nn = 0; nn < 2; ++nn) {
                const int nt = (wid & 1) * 2 + nn;
                f32x4 acc = (f32x4){0.f, 0.f, 0.f, 0.f};
                if (nt <= mt) {
#pragma unroll
                    for (int ks = 0; ks < 4; ++ks) {
                        const bf16x8 a = *(const bf16x8*)(QD + (mt * 16 + fr) * 136 + ks * 32 + fq * 8);
                        const bf16x8 bb = *(const bf16x8*)(KD + (nt * 16 + fr) * 136 + ks * 32 + fq * 8);
                        acc = __builtin_amdgcn_mfma_f32_16x16x32_bf16(bb, a, acc, 0, 0, 0);
                    }
                }
                const int t = mt * 16 + fr, s0 = nt * 16 + 4 * fq;
#pragma unroll
                for (int j = 0; j < 4; ++j) if (s0 + j > t) acc[j] = 0.f;
                *(u32x2*)(SC + t * 72 + s0) = pack4(acc);
            }
        }
        __syncthreads();
        {
#pragma unroll
            for (int nn = 0; nn < 2; ++nn) {
                const int dv0 = wid * 32 + nn * 16;
                bf16x8 bv[2];
#pragma unroll
                for (int ks = 0; ks < 2; ++ks) bv[ks] = *(const bf16x8*)(VT + (dv0 + fr) * 72 + ks * 32 + fq * 8);
                for (int mt = 0; mt < (L >> 4); ++mt) {
                    f32x4 acc = (f32x4){0.f, 0.f, 0.f, 0.f};
#pragma unroll
                    for (int ks = 0; ks < 2; ++ks) {
                        const bf16x8 a = *(const bf16x8*)(SC + (mt * 16 + fr) * 72 + ks * 32 + fq * 8);
                        acc = __builtin_amdgcn_mfma_f32_16x16x32_bf16(bv[ks], a, acc, 0, 0, 0);
                    }
                    *(u32x2*)(OB + (size_t)(row0 + mt * 16 + fr) * D + h * 256 + dv0 + 4 * fq) = pack4(acc);
                }
            }
        }
    }
}

__device__ void phase_gla_inter(const Ctx& p, unsigned char* lds, int i, const int pass) {
    const bf16_t* PROJ = (const bf16_t*)(p.ws + WS_BIG);
    bf16_t* OB = (bf16_t*)(p.ws + WS_H);
    const float* DEC = (const float*)(p.ws + WS_DEC);
    const int tid = p.tid, wid = tid >> 6, lane = tid & 63, fr = lane & 15, fq = lane >> 4;
    constexpr int BUFB = 17408 + 18432 + 512;
    f32x4* GZ = (f32x4*)(p.ws + WS_GZ); float* GP = (float*)(p.ws + WS_GP);
    const int nitem = pass == 0 ? 240 + 64 : 256;
    for (int item = p.bid; item < nitem; item += p.nb) {
        int seq, h, half, seg = 0; bool with_o = true, to_z = false;
        if (pass == 0 && item >= 240) { const int j = item - 240; seq = 2 + (j >> 3); h = (j >> 1) & 3; half = j & 1; }
        else if (pass == 0) { seg = item % 15; const int j = item / 15; seq = j >> 3; h = (j >> 1) & 3; half = j & 1; with_o = false; to_z = true; }
        else { seg = item & 15; const int j = item >> 4; seq = j >> 3; h = (j >> 1) & 3; half = j & 1; }
        const int smp = seq >= 2, b = smp ? seq - 2 : seq, L = smp ? 32 : 64, nch = smp ? 1 : 16, ch0 = smp ? 512 + b : b * 256 + seg * 16;
        const int dv0 = half * 128 + wid * 16;
        const float* s_init = smp ? PAR(5) + ((size_t)(i * 8 + b) * 4 + h) * 32768 : nullptr;
        float* s_out = p.out + (smp ? O_SGLA + ((size_t)(i * 8 + b) * 4 + h) * 32768 : O_PGLA + ((size_t)(i * 2 + b) * 4 + h) * 32768);
        f32x4 S[8], Pacc[8];
#pragma unroll
        for (int kt = 0; kt < 8; ++kt) { S[kt] = (f32x4){0.f, 0.f, 0.f, 0.f}; Pacc[kt] = (f32x4){1.f, 1.f, 1.f, 1.f}; }
        if (s_init) {
#pragma unroll
            for (int kt = 0; kt < 8; ++kt)
#pragma unroll
                for (int j = 0; j < 4; ++j) S[kt][j] = s_init[(size_t)(kt * 16 + 4 * fq + j) * 256 + dv0 + fr];
        } else if (pass == 1) {
            for (int sj = 0; sj < seg; ++sj) {
                const f32x4* zp = GZ + ((((size_t)((seq * 4 + h) * 2 + half) * 15 + sj) * 8 + wid) * 8) * 64 + lane;
                const float* pp = GP + ((size_t)(seq * 4 + h) * 15 + sj) * 128 + 4 * fq;
#pragma unroll
                for (int kt = 0; kt < 8; ++kt) S[kt] = S[kt] * *(const f32x4*)(pp + kt * 16) + zp[kt * 64];
            }
        }
        __syncthreads();
#define GLA_BAR() do { asm volatile("s_waitcnt lgkmcnt(0)" ::: "memory"); __builtin_amdgcn_s_barrier(); asm volatile("" ::: "memory"); } while (0)
        u32x4 gq[2][2], gk[2][2]; f32x4 gd[2]; bf16x8 gv[2]; u32x2 go[4];
        const int r_ = tid >> 3, part_ = tid & 7;
#define GLA_LOAD_QK(c, SET) do { int row0_, LL_; chunk_info(ch0 + (c), row0_, LL_); \
            if (r_ < L) { const bf16_t* q_ = PROJ + (size_t)(row0_ + r_) * NIN + h * 128 + part_ * 16; gq[SET][0] = *(const u32x4*)q_; gq[SET][1] = *(const u32x4*)(q_ + 8); \
                          const bf16_t* k_ = q_ + 512; gk[SET][0] = *(const u32x4*)k_; gk[SET][1] = *(const u32x4*)(k_ + 8); } \
            if (tid < 32) gd[SET] = *(const f32x4*)(DEC + ((size_t)(ch0 + (c)) * 4 + h) * 128 + tid * 4); } while (0)
#define GLA_STORE_LDS(buf, SET) do { unsigned char* base_ = lds + (buf) * BUFB; bf16_t* QD_ = (bf16_t*)base_; bf16_t* KT_ = (bf16_t*)(base_ + 17408); float* DC_ = (float*)(base_ + 17408 + 18432); \
            if (r_ < L) { *(u32x4*)(QD_ + r_ * 136 + part_ * 16) = gq[SET][0]; *(u32x4*)(QD_ + r_ * 136 + part_ * 16 + 8) = gq[SET][1]; \
                          const int e_ = r_ * 128 + part_ * 16, d_ = e_ / L, tk_ = e_ % L; *(u32x4*)(KT_ + d_ * 72 + tk_) = gk[SET][0]; *(u32x4*)(KT_ + d_ * 72 + tk_ + 8) = gk[SET][1]; } \
            if (tid < 32) *(f32x4*)(DC_ + tid * 4) = gd[SET]; } while (0)
        auto load_vo = [&](int c) {
            int row0, LL; chunk_info(ch0 + c, row0, LL);
#pragma unroll
            for (int ks = 0; ks < 2; ++ks) if (ks * 32 < L) {
                const int e = (dv0 + fr) * L + ks * 32 + 8 * fq;
                gv[ks] = *(const bf16x8*)(PROJ + (size_t)(row0 + (e >> 8)) * NIN + 1024 + h * 256 + (e & 255));
            }
#pragma unroll
            for (int mt = 0; mt < 4; ++mt) if (mt * 16 < L && with_o) go[mt] = *(const u32x2*)(OB + (size_t)(row0 + mt * 16 + fr) * D + h * 256 + dv0 + 4 * fq);
        };
        auto compute = [&](int c, const bf16x8 (&cv)[2], const u32x2 (&co)[4]) {
            int row0, LL; chunk_info(ch0 + c, row0, LL);
            unsigned char* base = lds + (c & 1) * BUFB;
            const bf16_t* QD = (const bf16_t*)base; const bf16_t* KT = (const bf16_t*)(base + 17408); const float* DC = (const float*)(base + 17408 + 18432);
            bf16x8 sb[4];
#pragma unroll
            for (int ks = 0; ks < 4; ++ks) {
                const u32x2 lo = pack4(S[2 * ks]), hi = pack4(S[2 * ks + 1]);
                u32x4 w = (u32x4){lo.x, lo.y, hi.x, hi.y};
                sb[ks] = *(bf16x8*)&w;
            }
            if (with_o) {
#pragma unroll
            for (int mt = 0; mt < 4; ++mt) if (mt * 16 < L) {
                f32x4 acc = (f32x4){0.f, 0.f, 0.f, 0.f};
#pragma unroll
                for (int ks = 0; ks < 4; ++ks) {
                    const u32x2 a0 = *(const u32x2*)(QD + (mt * 16 + fr) * 136 + ks * 32 + 4 * fq);
                    const u32x2 a1 = *(const u32x2*)(QD + (mt * 16 + fr) * 136 + ks * 32 + 16 + 4 * fq);
                    u32x4 w = (u32x4){a0.x, a0.y, a1.x, a1.y};
                    acc = __builtin_amdgcn_mfma_f32_16x16x32_bf16(sb[ks], *(bf16x8*)&w, acc, 0, 0, 0);
                }
                const f32x4 o = acc + unpack4(co[mt]);
                *(u32x2*)(OB + (size_t)(row0 + mt * 16 + fr) * D + h * 256 + dv0 + 4 * fq) = pack4(o);
            }
            }
#pragma unroll
            for (int kt = 0; kt < 8; ++kt) {
                const f32x4 dc = *(const f32x4*)(DC + kt * 16 + 4 * fq);
                S[kt] *= dc; Pacc[kt] *= dc;
#pragma unroll
                for (int ks = 0; ks < 2; ++ks) if (ks * 32 < L) {
                    const bf16x8 kb = *(const bf16x8*)(KT + (kt * 16 + fr) * 72 + ks * 32 + 8 * fq);
                    S[kt] = __builtin_amdgcn_mfma_f32_16x16x32_bf16(kb, cv[ks], S[kt], 0, 0, 0);
                }
            }
        };
        GLA_LOAD_QK(0, 0); load_vo(0);
        if (nch > 1) GLA_LOAD_QK(1, 1);
        GLA_STORE_LDS(0, 0);
        GLA_BAR();
        for (int c = 0; c < nch; c += 2) {
            {
                bf16x8 cv[2] = {gv[0], gv[1]}; u32x2 co[4] = {go[0], go[1], go[2], go[3]};
                if (c + 1 < nch) load_vo(c + 1);
                if (c + 2 < nch) GLA_LOAD_QK(c + 2, 0);
                compute(c, cv, co);
                if (c + 1 < nch) GLA_STORE_LDS(1, 1);
                GLA_BAR();
            }
            if (c + 1 < nch) {
                bf16x8 cv[2] = {gv[0], gv[1]}; u32x2 co[4] = {go[0], go[1], go[2], go[3]};
                if (c + 2 < nch) load_vo(c + 2);
                if (c + 3 < nch) GLA_LOAD_QK(c + 3, 1);
                compute(c + 1, cv, co);
                if (c + 2 < nch) GLA_STORE_LDS(0, 0);
                GLA_BAR();
            }
        }
        __syncthreads();
#undef GLA_LOAD_QK
#undef GLA_STORE_LDS
#undef GLA_BAR
        if (to_z) {
            f32x4* zp = GZ + ((((size_t)((seq * 4 + h) * 2 + half) * 15 + seg) * 8 + wid) * 8) * 64 + lane;
#pragma unroll
            for (int kt = 0; kt < 8; ++kt) zp[kt * 64] = S[kt];
            if (half == 0 && wid == 0 && fr == 0) {
                float* pp = GP + ((size_t)(seq * 4 + h) * 15 + seg) * 128 + 4 * fq;
#pragma unroll
                for (int kt = 0; kt < 8; ++kt) *(f32x4*)(pp + kt * 16) = Pacc[kt];
            }
        } else if (smp || seg == 15) {
#pragma unroll
            for (int kt = 0; kt < 8; ++kt)
#pragma unroll
                for (int j = 0; j < 4; ++j) s_out[(size_t)(kt * 16 + 4 * fq + j) * 256 + dv0 + fr] = S[kt][j];
        }
    }
}

__device__ void phase_gla_post(const Ctx& p, int i) {
    const bf16_t* PROJ = (const bf16_t*)(p.ws + WS_BIG);
    bf16_t* YC = (bf16_t*)(p.ws + WS_H);
    const float* gn = PAR(29) + i * 256;
    const int lane = p.tid & 63, wv = (p.bid * 512 + p.tid) >> 6, nw = (p.nb * 512) >> 6;
    const f32x4 gnv = *(const f32x4*)(gn + lane * 4);
    constexpr int NB = 4;
    for (int g0 = wv; g0 < MT * 4; g0 += nw * NB) {
        u32x2 ov[NB], gv[NB]; int rw[NB], cc[NB]; bool ok[NB];
#pragma unroll
        for (int k = 0; k < NB; ++k) {
            const int g = g0 + k * nw; ok[k] = g < MT * 4; const int gc = ok[k] ? g : g0;
            rw[k] = gc >> 2; cc[k] = (gc & 3) * 256 + lane * 4;
            ov[k] = *(const u32x2*)(YC + (size_t)rw[k] * D + cc[k]); gv[k] = *(const u32x2*)(PROJ + (size_t)rw[k] * NIN + 2048 + cc[k]);
        }
        float ss[NB];
#pragma unroll
        for (int k = 0; k < NB; ++k) { const f32x4 o = unpack4(ov[k]); ss[k] = o[0] * o[0] + o[1] * o[1] + o[2] * o[2] + o[3] * o[3]; }
#pragma unroll
        for (int of = 32; of > 0; of >>= 1) {
#pragma unroll
            for (int k = 0; k < NB; ++k) ss[k] += __shfl_xor(ss[k], of);
        }
#pragma unroll
        for (int k = 0; k < NB; ++k) {
            const float rs = rsqrtf(ss[k] * (1.0f / 256.0f) + 1e-6f);
            const f32x4 o = unpack4(ov[k]), gg = unpack4(gv[k]);
            f32x4 r;
#pragma unroll
            for (int j = 0; j < 4; ++j) r[j] = o[j] * rs * gnv[j] * gg[j] * sigmoidf_(gg[j]);
            if (ok[k]) *(u32x2*)(YC + (size_t)rw[k] * D + cc[k]) = pack4(r);
        }
    }
}

__global__ void __launch_bounds__(512, 2) fwd_megakernel(Params prm) {
    extern __shared__ __attribute__((aligned(16))) unsigned char shm[];
    cg::grid_group grid = cg::this_grid();
    int ph0 = prm.ph_lo;
    const int ph_hi = prm.ph_hi;
    if (threadIdx.x == 0) { *(volatile LAS unsigned*)((LAS unsigned char*)shm + 131072) = 0u; *(volatile LAS unsigned*)((LAS unsigned char*)shm + 131072 + 4) = 0u; }
    __syncthreads();
    const XcdBarrier xb = xcd_barrier_post((unsigned*)(prm.ws + WS_BAR), (volatile LAS unsigned*)((LAS unsigned char*)shm + 131072));
    if (ph0 == 0) {
        if (PHON(0)) phase_init(prm, shm);
        if (ph_hi > 1) grid.sync();
        ph0 = 1;
    }
    for (int ph = ph0; ph < ph_hi; ++ph) {
        Ctx p; size_t zoff = 0; p.tid = threadIdx.x; p.bid = blockIdx.x; p.nb = gridDim.x;
        asm volatile("" : "+s"(zoff), "+v"(p.tid), "+s"(p.bid), "+s"(p.nb));
        p.ws = prm.ws + zoff; p.out = (float*)((unsigned char*)prm.out + zoff);
        float* X = p.out;
        bf16_t* H = (bf16_t*)(p.ws + WS_H);
        bf16_t* BIG = (bf16_t*)(p.ws + WS_BIG);
        if (ph == NPH - 1) { if (PHON(11)) phase_final_norm(p, X, PAR(30)); }
        else {
            const int L = (ph - 1) / 13, st = (ph - 1) % 13, i = L >> 1, even = (L & 1) == 0;
            if (even && st == 8) continue;
            const int sub = st >= 10 ? 1 : 0;
            switch (st) {
            case 0: case 3: phase_rstd(p); break;
            case 10: if (PHON(1)) phase_norm(p, X, PAR(6) + (size_t)(L * 2 + 1) * D, H); break;
            case 1: case 11: if (PHON(2)) {
                pg8::Gemm g{H, w_gu(p.ws, L, sub), MT, 5632, 1024}; pg8::StaticOrder S; S.init(MT, 5632, p.nb, p.bid);
                pg8::EpiSwiGLU E{BIG, st == 1 ? (const float*)(p.ws + WS_RSTD) : nullptr};
                pg8::gemm_phase((LAS unsigned char*)shm, g, S, E, p.tid);
            } break;
            case 2: case 12: case 9: if (PHON(3)) {
                pg8::Gemm g; pg8::EpiResid E;
                const bool emit = st == 2 || (st == 12 && L < 3);
                bf16_t* xb = emit ? H : nullptr; float* ssp = (float*)(p.ws + WS_SSP);
                if (st == 9) { g = pg8::Gemm{H, w_out(p.ws, L), MP, 1024, 1024}; E = pg8::EpiResid{X, 1.0f, nullptr, ssp}; }
                else { g = pg8::Gemm{BIG, w_dn(p.ws, L, sub), MP, 1024, DFF}; E = pg8::EpiResid{X, 0.5f, xb, ssp}; }
                pg8::StaticOrder S; S.init(MP, 1024, p.nb, p.bid);
                pg8::gemm_phase((LAS unsigned char*)shm, g, S, E, p.tid);
                sample_gemm_splitk(p, shm, g.A, g.Bt, g.K, X, E.scale, E.XB, ssp);
            } break;
            case 4: if (PHON(4)) {
                pg8::Gemm g{H, w_in(p.ws, L), MT, NIN, 1024}; pg8::StaticOrder S; S.init(MT, NIN, p.nb, p.bid);
                pg8::EpiProj E{BIG, (bf16_t*)(p.ws + WS_HALO), (const float*)(p.ws + WS_RSTD)};
                pg8::gemm_phase((LAS unsigned char*)shm, g, S, E, p.tid);
            } break;
            case 5: if (even) { if (PHON(5)) phase_even_prep(p, shm, i); } else { if (PHON(8)) phase_gla_intra(p, shm, i); } break;
            case 6: case 7: if (even) { if (st == 6) { if (PHON(6)) phase_scan(p, shm, i); } else { if (PHON(7)) phase_even_post(p, i); } } else { if (PHON(9)) phase_gla_inter(p, shm, i, st - 6); } break;
            case 8: if (PHON(10)) phase_gla_post(p, i); break;
            default: break;
            }
        }
        if (ph + 1 < ph_hi) xcd_barrier(xb);
    }
}

extern "C" void kernel_launch(void* const* d_in, const int* in_sizes, int n_in, void* d_out, int out_size, void* d_ws, size_t ws_size, hipStream_t stream) {
    static int grid = 0;
    if (grid == 0) {
        bool bad = n_in != 31 || (size_t)out_size != O_END || ws_size < WS_END || in_sizes[0] != MP * D || in_sizes[1] != MS * D;
        for (int k = 0; k < NPAR && !bad; ++k) if ((size_t)in_sizes[PIDX[k]] != PSZ[k]) bad = true;
        if (bad) { fprintf(stderr, "kernel_launch: unexpected shapes\n"); grid = -1; return; }
        int dev = 0, cus = 0, per_cu = 0;
        hipGetDevice(&dev);
        hipDeviceGetAttribute(&cus, hipDeviceAttributeMultiprocessorCount, dev);
        if (hipFuncSetAttribute((const void*)fwd_megakernel, hipFuncAttributeMaxDynamicSharedMemorySize, LDS_BYTES) != hipSuccess) { fprintf(stderr, "kernel_launch: hipFuncSetAttribute failed\n"); grid = -1; return; }
        if (hipOccupancyMaxActiveBlocksPerMultiprocessor(&per_cu, (const void*)fwd_megakernel, 512, LDS_BYTES) != hipSuccess || per_cu < 1) { fprintf(stderr, "kernel_launch: occupancy query gave %d\n", per_cu); per_cu = 1; }
        (void)hipGetLastError();
        grid = cus * 1;
        if (grid > 256) grid = 256;
    }
    if (grid < 0) return;
    Params p{};
    for (int i = 0; i < 31; ++i) p.in[i] = (const float*)d_in[i];
    p.out = (float*)d_out; p.ws = (unsigned char*)d_ws;
    if (hipMemsetAsync((unsigned char*)d_ws + WS_BAR, 0, 16384, stream) != hipSuccess) { fprintf(stderr, "kernel_launch: memset of the barrier words failed\n"); return; }
    p.ph_lo = 0; p.ph_hi = NPH;
    void* args[] = {&p};
    hipError_t e = hipLaunchCooperativeKernel((const void*)fwd_megakernel, dim3(grid), dim3(512), args, LDS_BYTES, stream);
    if (e != hipSuccess) fprintf(stderr, "cooperative launch failed: %s (grid %d)\n", hipGetErrorString(e), grid);
}
```

```cpp
#include <hip/hip_runtime.h>
#include <hip/hip_cooperative_groups.h>
#include <cstdio>
namespace cg = cooperative_groups;

#ifndef PH_MASK
#define PH_MASK 0xFFFF
#endif
#define PHON(b) ((PH_MASK>>(b))&1)

typedef unsigned short bf16_t;
typedef short bf16x8 __attribute__((ext_vector_type(8)));
typedef float f32x4 __attribute__((ext_vector_type(4)));
typedef float f32x2 __attribute__((ext_vector_type(2)));
typedef unsigned u32x4 __attribute__((ext_vector_type(4)));
typedef unsigned u32x2 __attribute__((ext_vector_type(2)));
#define LAS __attribute__((address_space(3)))

constexpr int MP = 32768, MS = 256, MT = MP + MS;
constexpr int D = 1024, DFF = 2816, NIN = 3328;
constexpr int SEQ = 16384, DSEQ = 32;
constexpr int NPH = 2 + 4 * 13;

constexpr size_t O_Y = 0;
constexpr size_t O_PSHIFT = (size_t)MT * D;
constexpr size_t O_PWKV = O_PSHIFT + 2 * 2 * 1792;
constexpr size_t O_PCONV = O_PWKV + 2 * 2 * 8 * 4096;
constexpr size_t O_PGLA = O_PCONV + 2 * 2 * 2 * 512;
constexpr size_t O_SSHIFT = O_PGLA + (size_t)2 * 2 * 4 * 32768;
constexpr size_t O_SWKV = O_SSHIFT + 2 * 8 * 1792;
constexpr size_t O_SCONV = O_SWKV + (size_t)2 * 8 * 8 * 4096;
constexpr size_t O_SGLA = O_SCONV + 2 * 8 * 2 * 512;
constexpr size_t O_END = O_SGLA + (size_t)2 * 8 * 4 * 32768;

constexpr size_t GU_E = (size_t)5632 * 1024, DN_E = (size_t)1024 * 2816, IN_E = (size_t)3328 * 1024, OUT_E = (size_t)1024 * 1024;
constexpr size_t WL_E = 2 * (GU_E + DN_E) + IN_E + OUT_E;
constexpr size_t WS_WB = 0;
constexpr size_t WS_SMALL = WS_WB + 4 * WL_E * 2;
constexpr size_t SMALL_E = 512 * 64 * 2 + 512 * 128;
constexpr size_t WS_H = WS_SMALL + 2 * SMALL_E * 2;
constexpr size_t WS_BIG = WS_H + (size_t)MT * 1024 * 2;
constexpr size_t WS_HALO = WS_BIG + (size_t)MT * NIN * 2;
constexpr size_t WS_SCAL = WS_HALO + (size_t)(MT / 64) * 2 * NIN * 2;
constexpr size_t WS_DEC = WS_SCAL + (size_t)MT * 8 * 4 * 4;
constexpr size_t WS_PAR = WS_DEC + (size_t)520 * 4 * 128 * 4;
constexpr int NPAR = 19;
constexpr int PIDX[NPAR] = {2, 3, 4, 5, 6, 10, 13, 14, 16, 19, 20, 21, 22, 23, 24, 27, 28, 29, 30};
constexpr size_t PSZ[NPAR] = {28672, 524288, 16384, 2097152, 8192, 4096, 3584, 1024, 1024, 1024, 1024, 1024, 1024, 1024, 3072, 16384, 1024, 512, 1024};
constexpr size_t par_off(int idx) { size_t o = 0; for (int k = 0; k < NPAR; ++k) { if (PIDX[k] == idx) return o; o += PSZ[k]; } return o; }
constexpr size_t WS_GZ = WS_PAR + par_off(-1) * 4;
constexpr size_t WS_GP = WS_GZ + (size_t)2 * 4 * 2 * 15 * 65536;
constexpr size_t WS_BAR = WS_GP + (size_t)2 * 4 * 15 * 128 * 4;
constexpr size_t WS_SSP = WS_BAR + 16384;
constexpr size_t WS_RSTD = WS_SSP + (size_t)MT * 32 * 4;
constexpr size_t WS_END = WS_RSTD + (size_t)MT * 4;
#define PAR(idx) ((const float*)(p.ws + WS_PAR) + par_off(idx))

constexpr int LDS_BYTES = 131072 + 64;

struct Params {
    const float* in[31];
    float* out;
    unsigned char* ws;
    int ph_lo, ph_hi;
};

struct Ctx { unsigned char* ws; float* out; int tid, bid, nb; };

typedef __bf16 bf16x2_t __attribute__((ext_vector_type(2)));
__device__ __forceinline__ unsigned cvt_pk_bf16(float lo, float hi) { f32x2 v = {lo, hi}; bf16x2_t r = __builtin_convertvector(v, bf16x2_t); return __builtin_bit_cast(unsigned, r); }
__device__ __forceinline__ bf16_t f2bf(float x) { return (bf16_t)(cvt_pk_bf16(x, 0.f) & 0xffffu); }
__device__ __forceinline__ float bf2f(bf16_t b) { return __uint_as_float(((unsigned)b) << 16); }
__device__ __forceinline__ float bflo(unsigned u) { return __uint_as_float(u << 16); }
__device__ __forceinline__ float bfhi(unsigned u) { return __uint_as_float(u & 0xffff0000u); }
__device__ __forceinline__ f32x4 unpack4(u32x2 u) { return (f32x4){bflo(u.x), bfhi(u.x), bflo(u.y), bfhi(u.y)}; }
__device__ __forceinline__ u32x2 pack4(f32x4 v) { u32x2 r; r.x = cvt_pk_bf16(v[0], v[1]); r.y = cvt_pk_bf16(v[2], v[3]); return r; }
__device__ __forceinline__ float sigmoidf_(float x) { return __builtin_amdgcn_rcpf(1.0f + __expf(-x)); }
__device__ __forceinline__ float wave_sum(float v) {
#pragma unroll
    for (int o = 32; o > 0; o >>= 1) v += __shfl_xor(v, o);
    return v;
}
template <int CTRL, int RM = 0xf, int BM = 0xf> __device__ __forceinline__ float dppf(float x) { return __int_as_float(__builtin_amdgcn_update_dpp(0, __float_as_int(x), CTRL, RM, BM, true)); }

#define XB_TMO      128
#define XB_XCNT(j)  (256  + 64 * (j))
#define XB_XSUB(j)  (1280 + 64 * (j))
#define XB_XGEN(j)  (2304 + 64 * (j))
#define XB_TOP      3328
#define XB_TOPGEN   3392
#define XCD_BAR_WORDS 3456
#define XB_SPIN_CAP (1u << 18)
__device__ __forceinline__ unsigned xb_ld(unsigned* p)              { return __hip_atomic_load(p, __ATOMIC_RELAXED, __HIP_MEMORY_SCOPE_AGENT); }
__device__ __forceinline__ unsigned xb_add(unsigned* p, unsigned v) { return __hip_atomic_fetch_add(p, v, __ATOMIC_RELAXED, __HIP_MEMORY_SCOPE_AGENT); }
__device__ __forceinline__ unsigned xb_xcc_id() { return (unsigned)__builtin_amdgcn_s_getreg((3 << 11) | 20) & 0xFu; }
#define XB_SPIN(cond, bar) do { unsigned _sp = 0; while (cond) { __builtin_amdgcn_s_sleep(1); \
    if ((++_sp & 255u) == 0u) { if (xb_ld(&(bar)[XB_TMO])) break; if (_sp > XB_SPIN_CAP) { atomicAdd(&(bar)[XB_TMO], 1u); break; } } } } while (0)
struct XcdBarrier { unsigned* bar; unsigned x; volatile LAS unsigned* st; };
__device__ __forceinline__ XcdBarrier xcd_barrier_post(unsigned* bar, volatile LAS unsigned* st) {
    XcdBarrier b; b.bar = bar; b.x = xb_xcc_id(); b.st = st;
    if (threadIdx.x == 0) (void)xb_add(&bar[XB_XCNT(b.x)], 1u);
    return b;
}
__device__ __forceinline__ void xcd_barrier_complete(unsigned* bar, unsigned x, unsigned& nloc, unsigned& nx) {
    const unsigned G = gridDim.x * gridDim.y * gridDim.z;
    unsigned sum, cnt, mine, sp = 0u;
    for (;;) {
        sum = 0u; cnt = 0u; mine = 0u;
#pragma unroll
        for (unsigned j = 0; j < 16; ++j) { const unsigned c = xb_ld(&bar[XB_XCNT(j)]); sum += c; cnt += (c > 0u) ? 1u : 0u; mine = (j == x) ? c : mine; }
        if (sum == G) break;
        __builtin_amdgcn_s_sleep(1);
        if ((++sp & 255u) == 0u) { if (xb_ld(&bar[XB_TMO])) break; if (sp > XB_SPIN_CAP) { atomicAdd(&bar[XB_TMO], 1u); break; } }
    }
    nloc = mine > 0u ? mine : 1u; nx = cnt > 0u ? cnt : 1u;
}
__device__ __forceinline__ void xcd_barrier(const XcdBarrier& b) {
    asm volatile("s_waitcnt vmcnt(0)" ::: "memory");
    __syncthreads();
    if (threadIdx.x == 0) {
        unsigned* bar = b.bar;
        __builtin_amdgcn_s_waitcnt(0);
        unsigned nloc = b.st[0], nx = b.st[1];
        if (nloc == 0u) { xcd_barrier_complete(bar, b.x, nloc, nx); b.st[0] = nloc; b.st[1] = nx; }
        const unsigned old = xb_add(&bar[XB_XSUB(b.x)], 1u);
        const unsigned gen = old / nloc;
        if (old + 1u == (gen + 1u) * nloc) {
            __builtin_amdgcn_fence(__ATOMIC_RELEASE, "agent");
            asm volatile("s_waitcnt vmcnt(0)" ::: "memory");
            const unsigned og = xb_add(&bar[XB_TOP], 1u);
            const unsigned tg = og / nx;
            if (og + 1u == (tg + 1u) * nx) xb_add(&bar[XB_TOPGEN], 1u);
            else XB_SPIN(xb_ld(&bar[XB_TOPGEN]) == tg, bar);
            __builtin_amdgcn_fence(__ATOMIC_ACQUIRE, "agent");
            xb_add(&bar[XB_XGEN(b.x)], 1u);
            asm volatile("s_waitcnt vmcnt(0)" ::: "memory");
        } else {
            XB_SPIN(xb_ld(&bar[XB_XGEN(b.x)]) == gen, bar);
            __builtin_amdgcn_fence(__ATOMIC_ACQUIRE, "agent");
            asm volatile("s_waitcnt vmcnt(0)" ::: "memory");
        }
    }
    __syncthreads();
}

namespace pg8 {
constexpr int BM = 256, BK = 64, HALF = 128, HTB = HALF * BK * 2, STAGE_BYTES = 8 * HTB, NXCD = 8, WGM = 8;
__device__ __forceinline__ int lds_byte(int r, int c) { const int st = (r >> 4) * 2 + (c >> 5), rr = r & 15, cc = c & 31, ob = rr * 64 + cc * 2; return st * 1024 + (ob ^ (((ob >> 9) & 1) << 5)); }
__device__ __forceinline__ void stage_rc(int b, int& R, int& C) { const int st = b / 1024, sb = b % 1024, swz = sb ^ (((sb >> 9) & 1) << 5); R = (st >> 1) * 16 + swz / 64; C = (st & 1) * 32 + (swz % 64) / 2; }
__device__ __forceinline__ int perm32(int rho) { const int n = rho >> 4, i = rho & 15; return 8 * (i >> 2) + 4 * n + (i & 3); }
struct Unit { int pm, pn; };
struct Gemm { const bf16_t* A; const bf16_t* Bt; int M, N, K; };
struct StaticOrder {
    int nM, nN, nwg, G, c;
    __device__ void init(int M, int N, int G_, int c_) { nM = M / BM; nN = N / BM; nwg = nM * nN; G = G_; c = c_; }
    __device__ bool next(int i, Unit& u) const {
        const long L = (long)i * G + c; if (L >= nwg) return false;
        int wgid = (int)L; { const int q = nwg / NXCD, r = nwg % NXCD, xcd = wgid % NXCD, off = wgid / NXCD; wgid = (xcd < r ? xcd * (q + 1) : r * (q + 1) + (xcd - r) * q) + off; }
        const int nig = WGM * nN, gid = wgid / nig, fm = gid * WGM, gsz = (nM - fm) < WGM ? (nM - fm) : WGM;
        u.pm = fm + ((wgid % nig) % gsz); u.pn = (wgid % nig) / gsz; return true;
    }
};

template <class Epi>
__device__ __forceinline__ void gemm_phase(LAS unsigned char* lds, const Gemm g, const StaticOrder& S, const Epi& E, const int tid) {
    const int wid = __builtin_amdgcn_readfirstlane(tid >> 6), lane = tid & 63, wr = wid >> 2, wc = wid & 3, fr = lane & 15, fq = lane >> 4;
    const int K = g.K, nt = K / BK;
    unsigned voffA[2], voffB[2];
#pragma unroll
    for (int i = 0; i < 2; ++i) { int R, C; stage_rc(tid * 16 + i * 8192, R, C); const int Rb = Epi::PERM ? ((R & ~31) + perm32(R & 31)) : R;
        voffA[i] = (unsigned)(R * K + C) * 2u; voffB[i] = (unsigned)(Rb * K + C) * 2u; }
    const size_t kstep = (size_t)(BK * 2);
    const size_t hstep = (size_t)HALF * K * 2;
    const size_t tstep = 2 * hstep;
    const unsigned ldsw = (unsigned)wid * 1024u;
    const int aoff = lds_byte(wr * 64 + fr, fq * 8), boff = lds_byte(wc * 32 + fr, fq * 8);
#define PG8_SA(b, h) (((b) * 2 + (h)) * HTB)
#define PG8_SB(b, h) ((4 + (b) * 2 + (h)) * HTB)
#define PG8_STAGE(bufoff, gbase, voff) do { _Pragma("unroll") for (int _i = 0; _i < 2; ++_i) \
        __builtin_amdgcn_global_load_lds((const unsigned*)((const char*)(gbase) + (voff)[_i]), (LAS unsigned*)(lds + (bufoff) + ldsw + _i * 8192), 16, 0, 0); } while (0)
#define PG8_LDA(dst, b, h) do { _Pragma("unroll") for (int m = 0; m < 4; ++m) _Pragma("unroll") for (int k = 0; k < 2; ++k) dst[m][k] = *(const LAS bf16x8*)(lds + PG8_SA(b, h) + aoff + m * 2048 + k * 1024); } while (0)
#define PG8_LDB(dst, b, h) do { _Pragma("unroll") for (int n = 0; n < 2; ++n) _Pragma("unroll") for (int k = 0; k < 2; ++k) dst[n][k] = *(const LAS bf16x8*)(lds + PG8_SB(b, h) + boff + n * 2048 + k * 1024); } while (0)
#define PG8_MMA(ai, bj, At, Bt) do { __builtin_amdgcn_s_setprio(1); _Pragma("unroll") for (int m = 0; m < 4; ++m) _Pragma("unroll") for (int n = 0; n < 2; ++n) _Pragma("unroll") for (int k = 0; k < 2; ++k) \
        acc[ai][bj][m][n] = __builtin_amdgcn_mfma_f32_16x16x32_bf16(Bt[n][k], At[m][k], acc[ai][bj][m][n], 0, 0, 0); __builtin_amdgcn_s_setprio(0); } while (0)
#define PG8_WAIT_V(n) asm volatile("s_waitcnt vmcnt(" #n ")" ::: "memory")
#define PG8_WAIT_L(n) asm volatile("s_waitcnt lgkmcnt(" #n ")" ::: "memory")
#define PG8_BAR __builtin_amdgcn_s_barrier()
#define PG8_SCHED __builtin_amdgcn_sched_barrier(0)
    Unit cur, nxt; int ui = 0;
    if (!S.next(0, cur)) return;
    f32x4 acc[2][2][4][2];
#pragma unroll
    for (int a = 0; a < 2; ++a)
#pragma unroll
        for (int b = 0; b < 2; ++b)
#pragma unroll
            for (int m = 0; m < 4; ++m)
#pragma unroll
                for (int n = 0; n < 2; ++n) acc[a][b][m][n] = (f32x4){0.f, 0.f, 0.f, 0.f};
    bf16x8 At[4][2], B0[2][2], B1[2][2];
    const char* cA = (const char*)g.A + (size_t)cur.pm * tstep; const char* cB = (const char*)g.Bt + (size_t)cur.pn * tstep;
    PG8_STAGE(PG8_SB(0, 0), cB, voffB); PG8_STAGE(PG8_SA(0, 0), cA, voffA); PG8_STAGE(PG8_SB(0, 1), cB + hstep, voffB); PG8_STAGE(PG8_SA(0, 1), cA + hstep, voffA);
    if (wr == 1) PG8_BAR;
    PG8_WAIT_V(4); PG8_BAR;
    PG8_STAGE(PG8_SB(1, 0), cB + kstep, voffB); PG8_STAGE(PG8_SA(1, 0), cA + kstep, voffA); PG8_STAGE(PG8_SB(1, 1), cB + hstep + kstep, voffB);
    PG8_WAIT_V(6); PG8_BAR;
    for (;;) {
        const bool has_next = S.next(ui + 1, nxt);
        const char* nA = has_next ? (const char*)g.A + (size_t)nxt.pm * tstep : cA; const char* nB = has_next ? (const char*)g.Bt + (size_t)nxt.pn * tstep : cB;
        for (int t = 0; t < nt; t += 2) {
            const bool last = (t == nt - 2);
            const char* a1 = cA + (size_t)(t + 1) * kstep;
            const char* a2 = last ? nA : cA + (size_t)(t + 2) * kstep; const char* b2 = last ? nB : cB + (size_t)(t + 2) * kstep;
            const char* a3 = a2 + kstep; const char* b3 = b2 + kstep;
            PG8_LDB(B0, 0, 0); PG8_SCHED; PG8_LDA(At, 0, 0); PG8_STAGE(PG8_SA(1, 1), a1 + hstep, voffA);
            PG8_WAIT_L(8); PG8_BAR; PG8_WAIT_L(0); PG8_MMA(0, 0, At, B0); PG8_BAR; PG8_SCHED;
            PG8_LDB(B1, 0, 1); PG8_STAGE(PG8_SB(0, 0), b2, voffB);
            PG8_BAR; PG8_WAIT_L(0); PG8_MMA(0, 1, At, B1); PG8_BAR;
            PG8_LDA(At, 0, 1); PG8_STAGE(PG8_SA(0, 0), a2, voffA);
            PG8_BAR; PG8_WAIT_L(0); PG8_MMA(1, 0, At, B0); PG8_BAR; PG8_SCHED;
            PG8_STAGE(PG8_SB(0, 1), b2 + hstep, voffB);
            PG8_WAIT_V(6); PG8_BAR; PG8_MMA(1, 1, At, B1); PG8_BAR;
            PG8_LDB(B0, 1, 0); PG8_SCHED; PG8_LDA(At, 1, 0); PG8_STAGE(PG8_SA(0, 1), a2 + hstep, voffA);
            PG8_WAIT_L(8); PG8_BAR; PG8_WAIT_L(0); PG8_MMA(0, 0, At, B0); PG8_BAR; PG8_SCHED;
            PG8_LDB(B1, 1, 1); PG8_STAGE(PG8_SB(1, 0), b3, voffB);
            PG8_BAR; PG8_WAIT_L(0); PG8_MMA(0, 1, At, B1); PG8_BAR;
            PG8_LDA(At, 1, 1); PG8_STAGE(PG8_SA(1, 0), a3, voffA);
            PG8_BAR; PG8_WAIT_L(0); PG8_MMA(1, 0, At, B0); PG8_BAR; PG8_SCHED;
            PG8_STAGE(PG8_SB(1, 1), b3 + hstep, voffB);
            PG8_WAIT_V(6); PG8_BAR; PG8_MMA(1, 1, At, B1); PG8_BAR;
        }
        E(acc, cur, wr, wc, fr, fq);
        if (!has_next) break;
#pragma unroll
        for (int a = 0; a < 2; ++a)
#pragma unroll
            for (int b = 0; b < 2; ++b)
#pragma unroll
                for (int m = 0; m < 4; ++m)
#pragma unroll
                    for (int n = 0; n < 2; ++n) acc[a][b][m][n] = (f32x4){0.f, 0.f, 0.f, 0.f};
        cur = nxt; cA = nA; cB = nB; ++ui;
    }
    PG8_WAIT_V(0);
    if (wr == 0) PG8_BAR;
    PG8_BAR;
#undef PG8_SA
#undef PG8_SB
#undef PG8_STAGE
#undef PG8_LDA
#undef PG8_LDB
#undef PG8_MMA
#undef PG8_WAIT_V
#undef PG8_WAIT_L
#undef PG8_BAR
#undef PG8_SCHED
}

struct EpiSwiGLU {
    static constexpr bool PERM = true;
    bf16_t* O; const float* SSP;
    __device__ __forceinline__ void operator()(const f32x4 (&acc)[2][2][4][2], const Unit& u, int wr, int wc, int fr, int fq) const {
        const int row0 = u.pm * BM + wr * 64 + fr, col0 = u.pn * 128 + wc * 32 + 8 * fq;
        float rs8[2][4];
#pragma unroll
        for (int ai = 0; ai < 2; ++ai)
#pragma unroll
            for (int m = 0; m < 4; ++m) rs8[ai][m] = SSP ? SSP[row0 + ai * HALF + m * 16] : 1.0f;
#pragma unroll
        for (int ai = 0; ai < 2; ++ai)
#pragma unroll
            for (int m = 0; m < 4; ++m) {
                const int row = row0 + ai * HALF + m * 16;
                bf16_t* rowp = O + (size_t)row * DFF + col0;
                const float rs = rs8[ai][m];
                f32x4 r0, r1;
#pragma unroll
                for (int j = 0; j < 4; ++j) {
                    const float a0 = acc[ai][0][m][0][j] * rs, a1 = acc[ai][0][m][1][j] * rs;
                    r0[j] = a0 * __builtin_amdgcn_rcpf(1.0f + __expf(-a0)) * (acc[ai][1][m][0][j] * rs);
                    r1[j] = a1 * __builtin_amdgcn_rcpf(1.0f + __expf(-a1)) * (acc[ai][1][m][1][j] * rs);
                }
                u32x4 w; w.x = cvt_pk_bf16(r0[0], r0[1]); w.y = cvt_pk_bf16(r0[2], r0[3]); w.z = cvt_pk_bf16(r1[0], r1[1]); w.w = cvt_pk_bf16(r1[2], r1[3]);
                *(u32x4*)rowp = w;
            }
    }
};
struct EpiResid {
    static constexpr bool PERM = true;
    float* X; float scale; bf16_t* XB; float* SSP;
    __device__ __forceinline__ void operator()(const f32x4 (&acc)[2][2][4][2], const Unit& u, int wr, int wc, int fr, int fq) const {
        const int row0 = u.pm * BM + wr * 64 + fr, col0 = u.pn * BM + wc * 32 + 8 * fq;
#pragma unroll
        for (int ai = 0; ai < 2; ++ai)
#pragma unroll
            for (int m = 0; m < 4; ++m) { const int row = row0 + ai * HALF + m * 16; float* rowp = X + (size_t)row * D + col0; float sq = 0.f;
#pragma unroll
                for (int bj = 0; bj < 2; ++bj) {
                    float* pp = rowp + bj * HALF;
                    const f32x4 x0 = *(const f32x4*)pp + acc[ai][bj][m][0] * scale, x1 = *(const f32x4*)(pp + 4) + acc[ai][bj][m][1] * scale;
                    *(f32x4*)pp = x0; *(f32x4*)(pp + 4) = x1;
                    if (XB) { const u32x2 w0 = pack4(x0), w1 = pack4(x1);
                        *(u32x4*)(XB + (size_t)row * D + col0 + bj * HALF) = (u32x4){w0.x, w0.y, w1.x, w1.y};
                        sq += (x0[0] * x0[0] + x0[1] * x0[1] + x0[2] * x0[2] + x0[3] * x0[3]) + (x1[0] * x1[0] + x1[1] * x1[1] + x1[2] * x1[2] + x1[3] * x1[3]); } }
                if (XB) { sq += __shfl_xor(sq, 16); sq += __shfl_xor(sq, 32); if (fq == 0) SSP[(size_t)row * 32 + u.pn * 4 + wc] = sq; } }
    }
};
struct EpiProj {
    static constexpr bool PERM = true;
    bf16_t* O; bf16_t* halo; const float* SSP;
    __device__ __forceinline__ void operator()(const f32x4 (&acc)[2][2][4][2], const Unit& u, int wr, int wc, int fr, int fq) const {
        const int row0 = u.pm * BM + wr * 64 + fr, col0 = u.pn * BM + wc * 32 + 8 * fq;
        float rs8[2][4];
#pragma unroll
        for (int ai = 0; ai < 2; ++ai)
#pragma unroll
            for (int m = 0; m < 4; ++m) rs8[ai][m] = SSP[row0 + ai * HALF + m * 16];
#pragma unroll
        for (int ai = 0; ai < 2; ++ai)
#pragma unroll
            for (int m = 0; m < 4; ++m) { const int row = row0 + ai * HALF + m * 16; bf16_t* rowp = O + (size_t)row * NIN + col0;
                const float rs = rs8[ai][m];
#pragma unroll
                for (int bj = 0; bj < 2; ++bj) { const f32x4 v0 = acc[ai][bj][m][0] * rs, v1 = acc[ai][bj][m][1] * rs;
                    u32x4 w; w.x = cvt_pk_bf16(v0[0], v0[1]); w.y = cvt_pk_bf16(v0[2], v0[3]); w.z = cvt_pk_bf16(v1[0], v1[1]); w.w = cvt_pk_bf16(v1[2], v1[3]);
                    *(u32x4*)(rowp + bj * HALF) = w;
                    if (m == 3 && fr >= 14) *(u32x4*)(halo + ((size_t)(row >> 6) * 2 + (row & 1)) * NIN + col0 + bj * HALF) = w; } }
    }
};
}

__device__ __forceinline__ void sample_gemm_splitk(const Ctx& p, unsigned char* lds, const bf16_t* A, const bf16_t* Bt, const int K, float* X, const float scale, bf16_t* XB, float* SSP) {
    float* RED = (float*)lds;
    const int tid = p.tid, wid = tid >> 6, lane = tid & 63, fr = lane & 15, fq = lane >> 4;
    const int per = K / 256;
    for (int item = p.bid; item < 512; item += p.nb) {
        const int rt = item & 15, ct = item >> 4;
        const bf16_t* ap = A + (size_t)(MP + rt * 16 + fr) * K + 8 * fq + wid * per * 32;
        const bf16_t* b0 = Bt + (size_t)(ct * 32 + fr) * K + 8 * fq + wid * per * 32; const bf16_t* b1 = b0 + (size_t)16 * K;
        f32x4 acc0 = (f32x4){0.f, 0.f, 0.f, 0.f}, acc1 = acc0;
        for (int s0 = 0; s0 < per; s0 += 6) {
            bf16x8 a[6], x0[6], x1[6];
#pragma unroll
            for (int j = 0; j < 6; ++j) if (s0 + j < per) { a[j] = *(const bf16x8*)(ap + (s0 + j) * 32); x0[j] = *(const bf16x8*)(b0 + (s0 + j) * 32); x1[j] = *(const bf16x8*)(b1 + (s0 + j) * 32); }
#pragma unroll
            for (int j = 0; j < 6; ++j) if (s0 + j < per) {
                acc0 = __builtin_amdgcn_mfma_f32_16x16x32_bf16(x0[j], a[j], acc0, 0, 0, 0);
                acc1 = __builtin_amdgcn_mfma_f32_16x16x32_bf16(x1[j], a[j], acc1, 0, 0, 0);
            }
        }
        __syncthreads();
        *(f32x4*)(RED + (wid * 64 + lane) * 8) = acc0; *(f32x4*)(RED + (wid * 64 + lane) * 8 + 4) = acc1;
        __syncthreads();
        {
            const int ln = tid & 63, part = tid >> 6;
            float sum = 0.f;
#pragma unroll
            for (int w = 0; w < 8; ++w) sum += RED[(w * 64 + ln) * 8 + part];
            const int r16 = ln & 15, cidx = (part >> 2) * 16 + 4 * (ln >> 4) + (part & 3);
            float* xp = X + (size_t)(MP + rt * 16 + r16) * D + ct * 32 + cidx;
            const float xn = *xp + scale * sum; *xp = xn;
            if (XB) {
                XB[(size_t)(MP + rt * 16 + r16) * D + ct * 32 + cidx] = f2bf(xn);
                __syncthreads();
                RED[r16 * 32 + cidx] = xn * xn;
                __syncthreads();
                if (tid < 16) { float q = 0.f;
#pragma unroll
                    for (int c2 = 0; c2 < 32; ++c2) q += RED[tid * 32 + c2];
                    SSP[(size_t)(MP + rt * 16 + tid) * 32 + ct] = q; }
            }
        }
    }
}

__device__ __forceinline__ void tconv(unsigned char* lds, const float* src, int K, int N, int Npad, bf16_t* dst, int gu_half, const float* gk = nullptr) {
    constexpr int NT = 1;
    float* tile = (float*)lds;
    const int t = threadIdx.x, tk = K >> 6, tn = Npad >> 6, ntile = tk * tn;
    for (int tl0 = blockIdx.x; tl0 < ntile; tl0 += NT * gridDim.x) {
        f32x4 v[NT][2];
#pragma unroll
        for (int u = 0; u < NT; ++u) {
            const int tl = tl0 + u * gridDim.x;
            if (tl < ntile) {
                const int k0 = (tl % tk) * 64, n0 = (tl / tk) * 64;
#pragma unroll
                for (int i = 0; i < 2; ++i) {
                    const int k = (t >> 4) + 32 * i, n4 = (t & 15) * 4;
                    v[u][i] = (f32x4){0.f, 0.f, 0.f, 0.f};
                    if (n0 + n4 < N) v[u][i] = *(const f32x4*)(src + (size_t)(k0 + k) * N + n0 + n4);
                    if (gk) v[u][i] *= gk[k0 + k];
                }
            }
        }
        __syncthreads();
#pragma unroll
        for (int u = 0; u < NT; ++u) {
            if (tl0 + u * gridDim.x < ntile) {
#pragma unroll
                for (int i = 0; i < 2; ++i) {
                    const int k = (t >> 4) + 32 * i, n4 = (t & 15) * 4; float* tp = tile + u * (64 * 65) + k * 65 + n4;
                    tp[0] = v[u][i][0]; tp[1] = v[u][i][1]; tp[2] = v[u][i][2]; tp[3] = v[u][i][3];
                }
            }
        }
        __syncthreads();
#pragma unroll
        for (int u = 0; u < NT; ++u) {
            const int tl = tl0 + u * gridDim.x;
            if (tl < ntile) {
                const int k0 = (tl % tk) * 64, n0 = (tl / tk) * 64;
                const int n = t >> 3, kc = (t & 7) * 8; const float* tp = tile + u * (64 * 65);
                u32x4 w;
                w.x = cvt_pk_bf16(tp[(kc + 0) * 65 + n], tp[(kc + 1) * 65 + n]); w.y = cvt_pk_bf16(tp[(kc + 2) * 65 + n], tp[(kc + 3) * 65 + n]);
                w.z = cvt_pk_bf16(tp[(kc + 4) * 65 + n], tp[(kc + 5) * 65 + n]); w.w = cvt_pk_bf16(tp[(kc + 6) * 65 + n], tp[(kc + 7) * 65 + n]);
                const int nn = n0 + n, drow = gu_half < 0 ? nn : (((nn >> 7) << 8) + gu_half * 128 + (nn & 127));
                *(u32x4*)(dst + (size_t)drow * K + k0 + kc) = w;
            }
        }
    }
}
__device__ __forceinline__ bf16_t* wl_base(unsigned char* ws, int L) { return (bf16_t*)(ws + WS_WB) + (size_t)L * WL_E; }
__device__ __forceinline__ bf16_t* w_gu(unsigned char* ws, int L, int sub) { return wl_base(ws, L) + (size_t)sub * (GU_E + DN_E); }
__device__ __forceinline__ bf16_t* w_dn(unsigned char* ws, int L, int sub) { return w_gu(ws, L, sub) + GU_E; }
__device__ __forceinline__ bf16_t* w_in(unsigned char* ws, int L) { return wl_base(ws, L) + 2 * (GU_E + DN_E); }
__device__ __forceinline__ bf16_t* w_out(unsigned char* ws, int L) { return w_in(ws, L) + IN_E; }
__device__ __forceinline__ bf16_t* w_small(unsigned char* ws, int i) { return (bf16_t*)(ws + WS_SMALL) + (size_t)i * SMALL_E; }

__device__ void phase_init(const Params& p, unsigned char* lds) {
    {
        const int lane = threadIdx.x & 63, wv = (blockIdx.x * 512 + threadIdx.x) >> 6, nw = (gridDim.x * 512) >> 6;
        bf16_t* H = (bf16_t*)(p.ws + WS_H); float* SSP = (float*)(p.ws + WS_SSP);
        for (int row = wv; row < MT; row += nw) {
            const f32x4* x = (const f32x4*)(row < MP ? p.in[0] + (size_t)row * D : p.in[1] + (size_t)(row - MP) * D);
            f32x4* d = (f32x4*)(p.out + (size_t)row * D);
            f32x4 v[4]; float ss = 0.f;
#pragma unroll
            for (int i = 0; i < 4; ++i) { v[i] = x[lane + 64 * i]; ss += v[i][0] * v[i][0] + v[i][1] * v[i][1] + v[i][2] * v[i][2] + v[i][3] * v[i][3]; }
            ss = wave_sum(ss);
#pragma unroll
            for (int i = 0; i < 4; ++i) { d[lane + 64 * i] = v[i]; *(u32x2*)(H + (size_t)row * D + (lane + 64 * i) * 4) = pack4(v[i]); }
            if (lane < 32) SSP[(size_t)row * 32 + lane] = lane == 0 ? ss : 0.f;
        }
    }
    {
        float* par = (float*)(p.ws + WS_PAR);
        const size_t st = (size_t)gridDim.x * blockDim.x, t0 = (size_t)blockIdx.x * blockDim.x + threadIdx.x;
#pragma unroll
        for (int k = 0; k < NPAR; ++k) {
            const f32x4* src = (const f32x4*)p.in[PIDX[k]]; f32x4* dst = (f32x4*)(par + par_off(PIDX[k]));
            for (size_t e = t0; e < PSZ[k] / 4; e += st) dst[e] = src[e];
        }
    }
    for (int L = 0; L < 4; ++L) {
        const int i = L >> 1;
        for (int sub = 0; sub < 2; ++sub) {
            const size_t o = (size_t)(L * 2 + sub) * 1024 * 2816;
            const float* gk = sub == 0 ? p.in[6] + (size_t)(L * 2) * 1024 : nullptr;
            tconv(lds, p.in[7] + o, 1024, 2816, 2816, w_gu(p.ws, L, sub), 0, gk);
            tconv(lds, p.in[8] + o, 1024, 2816, 2816, w_gu(p.ws, L, sub), 1, gk);
            tconv(lds, p.in[9] + o, 2816, 1024, 1024, w_dn(p.ws, L, sub), -1);
        }
        if ((L & 1) == 0) {
            tconv(lds, p.in[11] + (size_t)i * 1024 * 3328, 1024, 3328, 3328, w_in(p.ws, L), -1, p.in[10] + (size_t)L * 1024);
            tconv(lds, p.in[12] + (size_t)i * 1024 * 1024, 1024, 1024, 1024, w_out(p.ws, L), -1);
            tconv(lds, p.in[15] + (size_t)i * 64 * 512, 64, 512, 512, w_small(p.ws, i), -1);
            tconv(lds, p.in[17] + (size_t)i * 64 * 512, 64, 512, 512, w_small(p.ws, i) + 512 * 64, -1);
            tconv(lds, p.in[18] + (size_t)i * 128 * 512, 128, 512, 512, w_small(p.ws, i) + 2 * 512 * 64, -1);
        } else {
            tconv(lds, p.in[25] + (size_t)i * 1024 * 3088, 1024, 3088, 3328, w_in(p.ws, L), -1, p.in[10] + (size_t)L * 1024);
            tconv(lds, p.in[26] + (size_t)i * 1024 * 1024, 1024, 1024, 1024, w_out(p.ws, L), -1);
        }
    }
}

__device__ void phase_norm(const Ctx& p, const float* X, const float* g, bf16_t* H) {
    const int lane = p.tid & 63, wv = (p.bid * 512 + p.tid) >> 6, nw = (p.nb * 512) >> 6;
    f32x4 gv[4];
#pragma unroll
    for (int i = 0; i < 4; ++i) gv[i] = *(const f32x4*)(g + (lane + 64 * i) * 4);
    for (int row = wv; row < MT; row += 2 * nw) {
        const int row1 = row + nw; const bool has1 = row1 < MT;
        const f32x4* x0 = (const f32x4*)(X + (size_t)row * D); const f32x4* x1 = (const f32x4*)(X + (size_t)(has1 ? row1 : row) * D);
        f32x4 v0[4], v1[4];
#pragma unroll
        for (int i = 0; i < 4; ++i) { v0[i] = x0[lane + 64 * i]; v1[i] = x1[lane + 64 * i]; }
        float s0 = 0.f, s1 = 0.f;
#pragma unroll
        for (int i = 0; i < 4; ++i) { s0 += v0[i][0] * v0[i][0] + v0[i][1] * v0[i][1] + v0[i][2] * v0[i][2] + v0[i][3] * v0[i][3]; s1 += v1[i][0] * v1[i][0] + v1[i][1] * v1[i][1] + v1[i][2] * v1[i][2] + v1[i][3] * v1[i][3]; }
#pragma unroll
        for (int o = 32; o > 0; o >>= 1) { s0 += __shfl_xor(s0, o); s1 += __shfl_xor(s1, o); }
        const float r0 = rsqrtf(s0 * (1.0f / 1024.0f) + 1e-6f), r1 = rsqrtf(s1 * (1.0f / 1024.0f) + 1e-6f);
#pragma unroll
        for (int i = 0; i < 4; ++i) *(u32x2*)(H + (size_t)row * D + (lane + 64 * i) * 4) = pack4(v0[i] * r0 * gv[i]);
        if (has1) {
#pragma unroll
            for (int i = 0; i < 4; ++i) *(u32x2*)(H + (size_t)row1 * D + (lane + 64 * i) * 4) = pack4(v1[i] * r1 * gv[i]);
        }
    }
}
__device__ void phase_rstd(const Ctx& p) {
    const float* SSP = (const float*)(p.ws + WS_SSP); float* RS = (float*)(p.ws + WS_RSTD);
    for (int row = p.bid * 512 + p.tid; row < MT; row += p.nb * 512) {
        const f32x4* q = (const f32x4*)(SSP + (size_t)row * 32);
        const f32x4 a = (q[0] + q[1]) + (q[2] + q[3]) + ((q[4] + q[5]) + (q[6] + q[7]));
        RS[row] = rsqrtf((a[0] + a[1] + a[2] + a[3]) * (1.0f / 1024.0f) + 1e-6f);
    }
}
__device__ void phase_final_norm(const Ctx& p, float* X, const float* g) {
    const int lane = p.tid & 63, wv = (p.bid * 512 + p.tid) >> 6, nw = (p.nb * 512) >> 6;
    f32x4 gv[4];
#pragma unroll
    for (int i = 0; i < 4; ++i) gv[i] = *(const f32x4*)(g + (lane + 64 * i) * 4);
    for (int row = wv; row < MT; row += nw) {
        f32x4* x = (f32x4*)(X + (size_t)row * D);
        f32x4 v[4]; float ss = 0.f;
#pragma unroll
        for (int i = 0; i < 4; ++i) { v[i] = x[lane + 64 * i]; ss += v[i][0] * v[i][0] + v[i][1] * v[i][1] + v[i][2] * v[i][2] + v[i][3] * v[i][3]; }
        ss = wave_sum(ss);
        const float rs = rsqrtf(ss * (1.0f / 1024.0f) + 1e-6f);
#pragma unroll
        for (int i = 0; i < 4; ++i) x[lane + 64 * i] = v[i] * rs * gv[i];
    }
}

struct RowInfo { int t, b, smp, len; };
__device__ __forceinline__ RowInfo row_info(int row) {
    RowInfo r;
    if (row < MP) { r.t = row & (SEQ - 1); r.b = row >> 14; r.smp = 0; r.len = SEQ; }
    else { const int q = row - MP; r.t = q & 31; r.b = q >> 5; r.smp = 1; r.len = DSEQ; }
    return r;
}

__device__ void phase_even_prep(const Ctx& p, unsigned char* lds, int i) {
    bf16_t* PROJ = (bf16_t*)(p.ws + WS_BIG);
    const bf16_t* HALO = (const bf16_t*)(p.ws + WS_HALO);
    bf16_t* YC = (bf16_t*)(p.ws + WS_H);
    float* SCAL = (float*)(p.ws + WS_SCAL);
    const float* st_shift = PAR(2) + (size_t)i * 8 * 1792;
    const float* st_conv = PAR(4) + (size_t)i * 8 * 2 * 512;
    const float* mu = PAR(13) + (size_t)i * 1792;
    const float* cw = PAR(24) + (size_t)i * 3 * 512;
    const bf16_t* wupT = w_small(p.ws, i); const bf16_t* aupT = wupT + 512 * 64; const bf16_t* gupT = wupT + 2 * 512 * 64;
    const int tid = p.tid, wid = tid >> 6, lane = tid & 63, fr = lane & 15, fq = lane >> 4;
    float* CST = (float*)lds;
    bf16_t* AW = (bf16_t*)(lds + 16384); bf16_t* AA = AW + 64 * 72; bf16_t* AG = AA + 64 * 72;
    {
        const int c = tid;
        CST[0 * 512 + c] = mu[c]; CST[1 * 512 + c] = mu[512 + c]; CST[2 * 512 + c] = mu[1024 + c];
        CST[3 * 512 + c] = (PAR(14) + i * 512)[c]; CST[4 * 512 + c] = (PAR(16) + i * 512)[c];
        CST[5 * 512 + c] = (PAR(19) + i * 512)[c]; CST[6 * 512 + c] = (PAR(20) + i * 512)[c]; CST[7 * 512 + c] = (PAR(21) + i * 512)[c];
    }
    const int th = tid >> 8;
    for (int tile = p.bid; tile < MT / 64; tile += p.nb) {
        const int row0 = tile * 64;
        __syncthreads();
        {
            const int cp2 = (tid & 255) * 2;
            const f32x2 cw0 = *(const f32x2*)(cw + cp2), cw1 = *(const f32x2*)(cw + 512 + cp2), cw2 = *(const f32x2*)(cw + 1024 + cp2);
            const int tk0 = th * 32, rowa = row0 + tk0; const RowInfo ra = row_info(rowa);
            f32x2 u1, u2;
            if (ra.t == 0) {
                if (ra.smp) { u2 = *(const f32x2*)(st_conv + (size_t)ra.b * 1024 + cp2); u1 = *(const f32x2*)(st_conv + (size_t)ra.b * 1024 + 512 + cp2); }
                else { u1 = (f32x2){0.f, 0.f}; u2 = u1; }
            } else {
                const bf16_t* h0 = (th == 0) ? HALO + ((size_t)(tile - 1) * 2) * NIN : PROJ + (size_t)(rowa - 2) * NIN; const bf16_t* h1 = h0 + NIN;
                const unsigned a0_ = *(const unsigned*)(h0 + 2304 + cp2), b0_ = *(const unsigned*)(h0 + 2816 + cp2), a1_ = *(const unsigned*)(h1 + 2304 + cp2), b1_ = *(const unsigned*)(h1 + 2816 + cp2);
                u2 = (f32x2){bflo(a0_) * bflo(b0_), bfhi(a0_) * bfhi(b0_)}; u1 = (f32x2){bflo(a1_) * bflo(b1_), bfhi(a1_) * bfhi(b1_)};
            }
            float* oc = p.out + (ra.smp ? O_SCONV + (size_t)(i * 8 + ra.b) * 1024 : O_PCONV + (size_t)(i * 2 + ra.b) * 1024);
#pragma unroll 1
            for (int bt = 0; bt < 4; ++bt) {
                unsigned gb[8], gc[8], hb[8];
#pragma unroll
                for (int j = 0; j < 8; ++j) { const bf16_t* pr = PROJ + (size_t)(rowa + bt * 8 + j) * NIN; gb[j] = *(const unsigned*)(pr + 1792 + cp2); gc[j] = *(const unsigned*)(pr + 2304 + cp2); hb[j] = *(const unsigned*)(pr + 2816 + cp2); }
                unsigned yo[8];
#pragma unroll
                for (int j = 0; j < 8; ++j) {
                    const f32x2 u0 = (f32x2){bflo(gc[j]) * bflo(hb[j]), bfhi(gc[j]) * bfhi(hb[j])};
                    const f32x2 y = (f32x2){bflo(gb[j]), bfhi(gb[j])} * (cw0 * u2 + cw1 * u1 + cw2 * u0);
                    yo[j] = cvt_pk_bf16(y.x, y.y);
                    const int t = ra.t + bt * 8 + j;
                    if (t >= ra.len - 2) *(f32x2*)(oc + (t - (ra.len - 2)) * 512 + cp2) = u0;
                    u2 = u1; u1 = u0;
                }
#pragma unroll
                for (int j = 0; j < 8; ++j) *(unsigned*)(YC + (size_t)(rowa + bt * 8 + j) * D + 512 + cp2) = yo[j];
            }
        }
        {
            const int lcol = tid & 255, pc = 1536 + lcol; const float mu_l = mu[pc];
            const int tk0 = th * 32, rowa = row0 + tk0; const RowInfo ra = row_info(rowa);
            float prev;
            if (ra.t == 0) prev = ra.smp ? st_shift[(size_t)ra.b * 1792 + pc] : 0.f;
            else prev = (th == 0) ? bf2f(HALO[((size_t)(tile - 1) * 2 + 1) * NIN + pc]) : bf2f(PROJ[(size_t)(rowa - 1) * NIN + pc]);
            bf16_t cu[32];
#pragma unroll
            for (int j = 0; j < 32; ++j) cu[j] = PROJ[(size_t)(rowa + j) * NIN + pc];
#pragma unroll
            for (int j = 0; j < 32; ++j) {
                const int tk = tk0 + j; const float cur = bf2f(cu[j]);
                const float xs = cur + (prev - cur) * mu_l;
                if (lcol < 64) AW[tk * 72 + lcol] = f2bf(tanhf(xs));
                else if (lcol < 128) AA[tk * 72 + lcol - 64] = f2bf(xs);
                else AG[((lcol - 128) >> 6) * (64 * 72) + tk * 72 + ((lcol - 128) & 63)] = f2bf(sigmoidf_(xs));
                prev = cur;
            }
            if (ra.t + 31 == ra.len - 1) p.out[(ra.smp ? O_SSHIFT + (size_t)(i * 8 + ra.b) * 1792 : O_PSHIFT + (size_t)(i * 2 + ra.b) * 1792) + pc] = prev;
        }
        __syncthreads();
        {
            const int h = wid;
            float a_n2[4] = {0.f, 0.f, 0.f, 0.f}, a_s1[4] = {0.f, 0.f, 0.f, 0.f}, a_s2[4] = {0.f, 0.f, 0.f, 0.f}, a_sb[4] = {0.f, 0.f, 0.f, 0.f};
#pragma unroll 1
            for (int n = 0; n < 4; ++n) {
                const int c = h * 64 + n * 16 + 4 * fq;
                bf16x8 bw[2], ba[2], bg[4];
#pragma unroll
                for (int ks = 0; ks < 2; ++ks) { bw[ks] = *(const bf16x8*)(wupT + (size_t)(h * 64 + n * 16 + fr) * 64 + ks * 32 + fq * 8); ba[ks] = *(const bf16x8*)(aupT + (size_t)(h * 64 + n * 16 + fr) * 64 + ks * 32 + fq * 8); }
#pragma unroll
                for (int ks = 0; ks < 4; ++ks) bg[ks] = *(const bf16x8*)(gupT + (size_t)(h * 64 + n * 16 + fr) * 128 + ks * 32 + fq * 8);
                u32x2 rc[2][3], rq[2][3];
#pragma unroll 1
                for (int m = 3; m >= 0; --m) {
                    if (m & 1) {
#pragma unroll
                        for (int mm = 0; mm < 2; ++mm) {
                            const int tk = (m - 1 + mm) * 16 + fr, row = row0 + tk; const RowInfo ri = row_info(row);
                            const bf16_t* pr = PROJ + (size_t)row * NIN + c;
#pragma unroll
                            for (int a = 0; a < 3; ++a) rc[mm][a] = *(const u32x2*)(pr + a * 512);
                            if (ri.t == 0) {
                                if (ri.smp) { const float* pf = st_shift + (size_t)ri.b * 1792 + c;
#pragma unroll
                                    for (int a = 0; a < 3; ++a) rq[mm][a] = pack4(*(const f32x4*)(pf + a * 512)); }
                                else {
#pragma unroll
                                    for (int a = 0; a < 3; ++a) rq[mm][a] = (u32x2){0u, 0u}; }
                            } else {
                                const bf16_t* pb = ((tk == 0) ? HALO + ((size_t)(tile - 1) * 2 + 1) * NIN : PROJ + (size_t)(row - 1) * NIN) + c;
#pragma unroll
                                for (int a = 0; a < 3; ++a) rq[mm][a] = *(const u32x2*)(pb + a * 512);
                            }
                        }
                    }
                    f32x4 in_c[3], in_q[3];
#pragma unroll
                    for (int a = 0; a < 3; ++a) {
                        const bool od = (m & 1) != 0;
                        u32x2 sc, sq; sc.x = od ? rc[1][a].x : rc[0][a].x; sc.y = od ? rc[1][a].y : rc[0][a].y; sq.x = od ? rq[1][a].x : rq[0][a].x; sq.y = od ? rq[1][a].y : rq[0][a].y;
                        in_c[a] = unpack4(sc); in_q[a] = unpack4(sq);
                    }
                    const f32x4 mur = *(const f32x4*)(CST + 0 * 512 + c), muk = *(const f32x4*)(CST + 1 * 512 + c), muv = *(const f32x4*)(CST + 2 * 512 + c), w0v = *(const f32x4*)(CST + 3 * 512 + c),
                                a0v = *(const f32x4*)(CST + 4 * 512 + c), kkv = *(const f32x4*)(CST + 5 * 512 + c), kav = *(const f32x4*)(CST + 6 * 512 + c), rkv = *(const f32x4*)(CST + 7 * 512 + c);
                    f32x4 dwn = (f32x4){0.f, 0.f, 0.f, 0.f}, dan = dwn, dgn = dwn;
#pragma unroll
                    for (int ks = 0; ks < 2; ++ks) {
                        const bf16x8 aw = *(const bf16x8*)(AW + (m * 16 + fr) * 72 + ks * 32 + fq * 8);
                        const bf16x8 aa = *(const bf16x8*)(AA + (m * 16 + fr) * 72 + ks * 32 + fq * 8);
                        dwn = __builtin_amdgcn_mfma_f32_16x16x32_bf16(bw[ks], aw, dwn, 0, 0, 0);
                        dan = __builtin_amdgcn_mfma_f32_16x16x32_bf16(ba[ks], aa, dan, 0, 0, 0);
                    }
#pragma unroll
                    for (int ks = 0; ks < 4; ++ks) {
                        const bf16x8 ag = *(const bf16x8*)(AG + (ks >> 1) * (64 * 72) + (m * 16 + fr) * 72 + (ks & 1) * 32 + fq * 8);
                        dgn = __builtin_amdgcn_mfma_f32_16x16x32_bf16(bg[ks], ag, dgn, 0, 0, 0);
                    }
                    const int tk = m * 16 + fr, row = row0 + tk; const RowInfo ri = row_info(row);
                    bf16_t* pr = PROJ + (size_t)row * NIN;
                    if (ri.t == ri.len - 1) {
                        float* osh = p.out + (ri.smp ? O_SSHIFT + (size_t)(i * 8 + ri.b) * 1792 : O_PSHIFT + (size_t)(i * 2 + ri.b) * 1792);
                        *(f32x4*)(osh + c) = in_c[0]; *(f32x4*)(osh + 512 + c) = in_c[1]; *(f32x4*)(osh + 1024 + c) = in_c[2];
                    }
                    const f32x4 xr = in_c[0] + (in_q[0] - in_c[0]) * mur, xk = in_c[1] + (in_q[1] - in_c[1]) * muk, xv = in_c[2] + (in_q[2] - in_c[2]) * muv;
                    f32x4 e, a; float t_n2 = 0.f, t_s1 = 0.f, t_s2 = 0.f, t_sb = 0.f;
#pragma unroll
                    for (int j = 0; j < 4; ++j) {
                        e[j] = sigmoidf_(w0v[j] + dwn[j]) * 0.60653065971f;
                        a[j] = sigmoidf_(a0v[j] + dan[j]);
                        const float kkr = xk[j] * kkv[j], kef = xk[j] * (1.0f + (a[j] - 1.0f) * kav[j]);
                        t_n2 += kkr * kkr; t_s1 += kkr * a[j] * xr[j]; t_s2 += kef * xr[j]; t_sb += xr[j] * kef * rkv[j];
                    }
#pragma unroll
                    for (int mm = 0; mm < 4; ++mm) { const bool on = (mm == m); a_n2[mm] += on ? t_n2 : 0.f; a_s1[mm] += on ? t_s1 : 0.f; a_s2[mm] += on ? t_s2 : 0.f; a_sb[mm] += on ? t_sb : 0.f; }
                    *(u32x2*)(pr + c) = pack4(xr); *(u32x2*)(pr + 512 + c) = pack4(xk); *(u32x2*)(pr + 1024 + c) = pack4(xv);
                    *(u32x2*)(pr + 1792 + c) = pack4(e); *(u32x2*)(pr + 2304 + c) = pack4(a); *(u32x2*)(pr + 2816 + c) = pack4(dgn);
                }
            }
#pragma unroll
            for (int m = 0; m < 4; ++m) {
                float n2 = a_n2[m], s1 = a_s1[m], s2 = a_s2[m], sb = a_sb[m];
                n2 += __shfl_xor(n2, 16); n2 += __shfl_xor(n2, 32);
                s1 += __shfl_xor(s1, 16); s1 += __shfl_xor(s1, 32);
                s2 += __shfl_xor(s2, 16); s2 += __shfl_xor(s2, 32);
                sb += __shfl_xor(sb, 16); sb += __shfl_xor(sb, 32);
                if (fq == 0) { const float inv = 1.0f / fmaxf(sqrtf(n2), 1e-12f); *(f32x4*)(SCAL + ((size_t)(row0 + m * 16 + fr) * 8 + h) * 4) = (f32x4){inv, s1 * inv, s2, sb}; }
            }
        }
    }
}

__device__ __forceinline__ void scan_consume(float& s, const f32x4* Q4, const float* KE, int lane, float vv, float c1, float c2, float& yout) {
    float rec0 = 0.f, rec1 = 0.f;
    const int l15 = lane & 15;
    f32x4 qa[8]; float ka[8];
#pragma unroll
    for (int u = 0; u < 8; ++u) { qa[u] = Q4[u * 64 + lane]; ka[u] = KE[u * 64 + lane]; }
#pragma unroll
    for (int g = 0; g < 4; ++g) {
        f32x4 qb[8]; float kb[8];
        if (g + 1 < 4) {
#pragma unroll
            for (int u = 0; u < 8; ++u) { qb[u] = Q4[((g + 1) * 8 + u) * 64 + lane]; kb[u] = KE[((g + 1) * 8 + u) * 64 + lane]; }
        }
#pragma unroll
        for (int u = 0; u < 8; ++u) {
            const int tt = g * 8 + u;
            const f32x4 q = qa[u];
            const float p1 = s * q[0], p2 = s * q[1];
            auto r = __builtin_amdgcn_permlane32_swap(__float_as_uint(p1), __float_as_uint(p2), false, false);
            float x = __uint_as_float(r[0]) + __uint_as_float(r[1]);
            x += dppf<0xB1>(x); x += dppf<0x4E>(x); x += dppf<0x141>(x); x += dppf<0x140>(x);
            const float sa0 = __int_as_float(__builtin_amdgcn_readlane(__float_as_int(x), 0));
            const float sa1 = __int_as_float(__builtin_amdgcn_readlane(__float_as_int(x), 16));
            const float vt = __int_as_float(__builtin_amdgcn_readlane(__float_as_int(vv), tt));
            float sn = fmaf(s, q[2], vt * ka[u]);
            sn = fmaf(-sa0, q[3], sn); s = fmaf(-sa1, q[3], sn);
            if (tt < 16) rec0 = (l15 == (tt & 15)) ? x : rec0; else rec1 = (l15 == (tt & 15)) ? x : rec1;
        }
        if (g + 1 < 4) {
#pragma unroll
            for (int u = 0; u < 8; ++u) { qa[u] = qb[u]; ka[u] = kb[u]; }
        }
        __builtin_amdgcn_sched_barrier(0);
    }
    const float a0 = __shfl(rec0, l15), a1 = __shfl(rec0, 16 + l15), b0 = __shfl(rec0, 32 + l15), b1 = __shfl(rec0, 48 + l15);
    const float a2 = __shfl(rec1, l15), a3 = __shfl(rec1, 16 + l15), b2 = __shfl(rec1, 32 + l15), b3 = __shfl(rec1, 48 + l15);
    const float sav = (lane < 16) ? a0 + a1 : a2 + a3, yav = (lane < 16) ? b0 + b1 : b2 + b3;
    yout = yav - sav * c1 + vv * c2;
}
__device__ void phase_scan(const Ctx& p, unsigned char* lds, int i) {
    const bf16_t* PROJ = (const bf16_t*)(p.ws + WS_BIG);
    bf16_t* YC = (bf16_t*)(p.ws + WS_H);
    const float* SCAL = (const float*)(p.ws + WS_SCAL);
    const float* k_k = PAR(19) + i * 512; const float* k_a = PAR(20) + i * 512;
    const int tid = p.tid, wid = tid >> 6, lane = tid & 63;
    f32x4* Q4 = (f32x4*)lds;
    float* KE = (float*)(lds + 65536);
    for (int job = p.bid; job < 512; job += p.nb) {
        int seq, h, rbase, rpw;
        if (job < 256) { seq = job >> 7; h = (job >> 4) & 7; rbase = (job & 15) * 4; rpw = 1; }
        else { const int j = job - 256; seq = 2 + (j >> 5); h = (j >> 2) & 7; rbase = (j & 3) * 16; rpw = 4; }
        const int smp = seq >= 2, b = smp ? seq - 2 : seq, row0 = smp ? MP + b * 32 : b * SEQ, len = smp ? DSEQ : SEQ, nch = len >> 5;
        const float* s_init = smp ? PAR(3) + ((size_t)(i * 8 + b) * 8 + h) * 4096 : nullptr;
        float* s_out = p.out + (smp ? O_SWKV + ((size_t)(i * 8 + b) * 8 + h) * 4096 : O_PWKV + ((size_t)(i * 2 + b) * 8 + h) * 4096);
        __syncthreads();
        if (wid >= 4) {
            const int pw = wid - 4, col = h * 64 + lane;
            const float kkc = k_k[col], kac = k_a[col];
            unsigned rxr[8], rxk[8], re[8], ra[8]; float rinv[8];
            auto load_raw = [&](int c) {
#pragma unroll
                for (int ii = 0; ii < 8; ++ii) {
                    const int row = row0 + c * 32 + pw * 8 + ii; const bf16_t* pr = PROJ + (size_t)row * NIN;
                    rxr[ii] = pr[col]; rxk[ii] = pr[512 + col]; re[ii] = pr[1792 + col]; ra[ii] = pr[2304 + col];
                    rinv[ii] = SCAL[((size_t)row * 8 + h) * 4];
                }
            };
            auto write_lds = [&](int c) {
                f32x4* q = Q4 + (c & 1) * 2048; float* ke = KE + (c & 1) * 2048;
#pragma unroll
                for (int ii = 0; ii < 8; ++ii) {
                    const int tt = pw * 8 + ii;
                    const float xr = bf2f((bf16_t)rxr[ii]), xk = bf2f((bf16_t)rxk[ii]), e = bf2f((bf16_t)re[ii]), a = bf2f((bf16_t)ra[ii]);
                    const float kk = xk * kkc * rinv[ii], w = __expf(-e);
                    q[tt * 64 + lane] = (f32x4){kk, w * xr, w, kk * a};
                    ke[tt * 64 + lane] = xk * (1.0f + (a - 1.0f) * kac);
                }
            };
            load_raw(0);
            for (int c = 0; c <= nch; ++c) {
                if (c < nch) {
                    write_lds(c);
                    if (c + 1 < nch) load_raw(c + 1);
                }
                __syncthreads();
            }
        } else if (rpw == 1) {
            __builtin_amdgcn_s_setprio(3);
            const int vrow = rbase + wid, vcol = 1024 + h * 64 + vrow;
            float s = s_init ? s_init[vrow * 64 + lane] : 0.f;
            float vv = 0.f, c1 = 0.f, c2 = 0.f;
            if (lane < 32) { const int row = row0 + lane; vv = bf2f(PROJ[(size_t)row * NIN + vcol]); const float* sc = SCAL + ((size_t)row * 8 + h) * 4; c1 = sc[1]; c2 = sc[2]; }
            __syncthreads();
            for (int c = 0; c < nch; ++c) {
                float vn = 0.f, c1n = 0.f, c2n = 0.f;
                if (c + 1 < nch && lane < 32) { const int row = row0 + (c + 1) * 32 + lane; vn = bf2f(PROJ[(size_t)row * NIN + vcol]); const float* sc = SCAL + ((size_t)row * 8 + h) * 4; c1n = sc[1]; c2n = sc[2]; }
                float y;
                scan_consume(s, Q4 + (c & 1) * 2048, KE + (c & 1) * 2048, lane, vv, c1, c2, y);
                if (lane < 32) YC[(size_t)(row0 + c * 32 + lane) * D + h * 64 + vrow] = f2bf(y);
                vv = vn; c1 = c1n; c2 = c2n;
                __syncthreads();
            }
            s_out[vrow * 64 + lane] = s;
            __builtin_amdgcn_s_setprio(0);
        } else {
            __syncthreads();
            for (int r = 0; r < 4; ++r) {
                const int vrow = rbase + wid * 4 + r, vcol = 1024 + h * 64 + vrow;
                float s = s_init[vrow * 64 + lane];
                float vv = 0.f, c1 = 0.f, c2 = 0.f;
                if (lane < 32) { const int row = row0 + lane; vv = bf2f(PROJ[(size_t)row * NIN + vcol]); const float* sc = SCAL + ((size_t)row * 8 + h) * 4; c1 = sc[1]; c2 = sc[2]; }
                float y;
                scan_consume(s, Q4, KE, lane, vv, c1, c2, y);
                if (lane < 32) YC[(size_t)(row0 + lane) * D + h * 64 + vrow] = f2bf(y);
                s_out[vrow * 64 + lane] = s;
            }
            __syncthreads();
        }
    }
}

__device__ void phase_even_post(const Ctx& p, int i) {
    const bf16_t* PROJ = (const bf16_t*)(p.ws + WS_BIG);
    bf16_t* YC = (bf16_t*)(p.ws + WS_H);
    const float* SCAL = (const float*)(p.ws + WS_SCAL);
    const float* lnw = PAR(22) + i * 512; const float* lnb = PAR(23) + i * 512;
    const int lane = p.tid & 63, wv = (p.bid * 512 + p.tid) >> 6, nw = (p.nb * 512) >> 6;
    const int l16 = lane & 15, sub = lane >> 4;
    constexpr int NB = 4;
    for (int g0 = wv * 4; g0 < MT * 8; g0 += nw * 4 * NB) {
        u32x2 yy[NB], vv[NB], gg[NB]; float cb[NB]; int rw[NB], cc[NB]; bool ok[NB];
#pragma unroll
        for (int k = 0; k < NB; ++k) {
            const int g = g0 + k * nw * 4 + sub; ok[k] = g < MT * 8; const int gc = ok[k] ? g : g0 + sub;
            rw[k] = gc >> 3; const int h = gc & 7; cc[k] = h * 64 + l16 * 4;
            yy[k] = *(const u32x2*)(YC + (size_t)rw[k] * D + cc[k]);
            vv[k] = *(const u32x2*)(PROJ + (size_t)rw[k] * NIN + 1024 + cc[k]); gg[k] = *(const u32x2*)(PROJ + (size_t)rw[k] * NIN + 2816 + cc[k]);
            cb[k] = SCAL[((size_t)rw[k] * 8 + h) * 4 + 3];
        }
        u32x2 oo[NB];
#pragma unroll
        for (int k = 0; k < NB; ++k) {
            const f32x4 y = unpack4(yy[k]);
            float sm = y[0] + y[1] + y[2] + y[3];
            sm += __shfl_xor(sm, 1); sm += __shfl_xor(sm, 2); sm += __shfl_xor(sm, 4); sm += __shfl_xor(sm, 8);
            const float mean = sm * (1.0f / 64.0f);
            const f32x4 d = y - mean;
            float vr = d[0] * d[0] + d[1] * d[1] + d[2] * d[2] + d[3] * d[3];
            vr += __shfl_xor(vr, 1); vr += __shfl_xor(vr, 2); vr += __shfl_xor(vr, 4); vr += __shfl_xor(vr, 8);
            const float rs = rsqrtf(vr * (1.0f / 64.0f) + 64e-5f);
            const f32x4 o = (d * rs * *(const f32x4*)(lnw + cc[k]) + *(const f32x4*)(lnb + cc[k]) + unpack4(vv[k]) * cb[k]) * unpack4(gg[k]);
            oo[k] = pack4(o);
        }
#pragma unroll
        for (int k = 0; k < NB; ++k) if (ok[k]) *(u32x2*)(YC + (size_t)rw[k] * D + cc[k]) = oo[k];
    }
}

__device__ __forceinline__ void chunk_info(int ch, int& row0, int& L) { if (ch < 512) { row0 = ch * 64; L = 64; } else { row0 = MP + (ch - 512) * 32; L = 32; } }
__device__ void phase_gla_intra(const Ctx& p, unsigned char* lds, int i) {
    bf16_t* PROJ = (bf16_t*)(p.ws + WS_BIG);
    bf16_t* OB = (bf16_t*)(p.ws + WS_H);
    float* DEC = (float*)(p.ws + WS_DEC);
    const float* a_up = PAR(27) + (size_t)i * 16 * 512; const float* a_b = PAR(28) + i * 512;
    const int tid = p.tid, wid = tid >> 6, lane = tid & 63, fr = lane & 15, fq = lane >> 4;
    bf16_t* QD = (bf16_t*)lds;
    bf16_t* KD = QD + 64 * 136;
    bf16_t* VT = KD + 64 * 136;
    bf16_t* SC = VT + 256 * 72;
    bf16_t* KE = SC + 64 * 72;
    float* ALO = (float*)(KE + 128 * 72);
    float* PS = ALO + 64 * 16;
    for (int item = p.bid; item < 520 * 4; item += p.nb) {
        const int ch = item >> 2, h = item & 3; int row0, L; chunk_info(ch, row0, L);
        __syncthreads();
        for (int e = tid; e < 64 * 16; e += 512) { const int tk = e >> 4, j = e & 15; ALO[e] = tk < L ? bf2f(PROJ[(size_t)(row0 + tk) * NIN + 3072 + j]) : 0.f; }
        for (int e = tid; e < 64 * 64; e += 512) {
            const int tk = e >> 6, d4 = (e & 63) * 4;
            u32x2 v = (u32x2){0u, 0u};
            if (tk < L) v = *(const u32x2*)(PROJ + (size_t)(row0 + tk) * NIN + 1024 + h * 256 + d4);
            VT[(d4 + 0) * 72 + tk] = (bf16_t)(v.x & 0xffffu); VT[(d4 + 1) * 72 + tk] = (bf16_t)(v.x >> 16);
            VT[(d4 + 2) * 72 + tk] = (bf16_t)(v.y & 0xffffu); VT[(d4 + 3) * 72 + tk] = (bf16_t)(v.y >> 16);
        }
        __syncthreads();
        {
            const int col = tid & 127, qr = tid >> 7, gc = h * 128 + col;
            float wv[16];
#pragma unroll
            for (int j = 0; j < 16; ++j) wv[j] = a_up[j * 512 + gc];
            const float bias = a_b[gc];
            float cum[16]; float run = 0.f;
#pragma unroll
            for (int t = 0; t < 16; ++t) {
                const int tk = qr * 16 + t;
                float x = bias;
#pragma unroll
                for (int j = 0; j < 16; ++j) x += ALO[tk * 16 + j] * wv[j];
                const float la = tk < L ? (fminf(x, 0.f) - __logf(1.0f + __expf(-fabsf(x)))) * (1.0f / 16.0f) : 0.f;
                run += la; cum[t] = run;
            }
            PS[qr * 128 + col] = run;
            __syncthreads();
            float pre = 0.f, tot = 0.f;
#pragma unroll
            for (int q = 0; q < 4; ++q) { const float v = PS[q * 128 + col]; tot += v; if (q < qr) pre += v; }
            unsigned kep[8];
            bf16_t qraw[16], kraw[16];
#pragma unroll
            for (int t = 0; t < 16; ++t) {
                const int tk = qr * 16 + t; const int tkc = tk < L ? tk : 0;
                qraw[t] = PROJ[(size_t)(row0 + tkc) * NIN + gc]; kraw[t] = PROJ[(size_t)(row0 + tkc) * NIN + 512 + gc];
            }
#pragma unroll
            for (int t = 0; t < 16; t += 2) {
                float kev[2];
#pragma unroll
                for (int u = 0; u < 2; ++u) {
                    const int tk = qr * 16 + t + u; const float cm = cum[t + u] + pre;
                    float q = 0.f, k = 0.f;
                    if (tk < L) { q = bf2f(qraw[t + u]); k = bf2f(kraw[t + u]); }
                    const float qd = q * 0.08838834764831845f * __expf(cm);
                    const bf16_t qdb = f2bf(qd);
                    QD[tk * 136 + col] = qdb; KD[tk * 136 + col] = f2bf(k * __expf(-cm));
                    kev[u] = k * __expf(tot - cm);
                    if (tk < L) PROJ[(size_t)(row0 + tk) * NIN + gc] = qdb;
                }
                kep[t >> 1] = cvt_pk_bf16(kev[0], kev[1]);
            }
            *(u32x4*)(KE + col * 72 + qr * 16) = (u32x4){kep[0], kep[1], kep[2], kep[3]};
            *(u32x4*)(KE + col * 72 + qr * 16 + 8) = (u32x4){kep[4], kep[5], kep[6], kep[7]};
            if (qr == 0) DEC[((size_t)ch * 4 + h) * 128 + col] = __expf(tot);
        }
        __syncthreads();
        {
            for (int e8 = tid; e8 < 128 * L / 8; e8 += 512) {
                const int e = e8 * 8, d = e / L, tk = e % L;
                const u32x4 v = *(const u32x4*)(KE + d * 72 + tk);
                *(u32x4*)(PROJ + (size_t)(row0 + (e >> 7)) * NIN + 512 + h * 128 + (e & 127)) = v;
            }
            for (int e8 = tid; e8 < 256 * L / 8; e8 += 512) {
                const int e = e8 * 8, d = e / L, tk = e % L;
                const u32x4 v = *(const u32x4*)(VT + d * 72 + tk);
                *(u32x4*)(PROJ + (size_t)(row0 + (e >> 8)) * NIN + 1024 + h * 256 + (e & 255)) = v;
            }
        }
        {
            const int mt = wid >> 1;
#pragma unroll
            for (int nn = 0; nn < 2; ++nn) {
                const int nt = (wid & 1) * 2 + nn;
                f32x4 acc = (f32x4){0.f, 0.f, 0.f, 0.f};
                if (nt <= mt) {
#pragma unroll
                    for (int ks = 0; ks < 4; ++ks) {
                        const bf16x8 a = *(const bf16x8*)(QD + (mt * 16 + fr) * 136 + ks * 32 + fq * 8);
                        const bf16x8 bb = *(const bf16x8*)(KD + (nt * 16 + fr) * 136 + ks * 32 + fq * 8);
                        acc = __builtin_amdgcn_mfma_f32_16x16x32_bf16(bb, a, acc, 0, 0, 0);
                    }
                }
                const int t = mt * 16 + fr, s0 = nt * 16 + 4 * fq;
#pragma unroll
                for (int j = 0; j < 4; ++j) if (s0 + j > t) acc[j] = 0.f;
                *(u32x2*)(SC + t * 72 + s0) = pack4(acc);
            }
        }
        __syncthreads();
        {
#pragma unroll
            for (int nn = 0; nn < 2; ++nn) {
                const int dv0 = wid * 32 + nn * 16;
                bf16x8 bv[2];
#pragma unroll
                for (int ks = 0; ks < 2; ++ks) bv[ks] = *(const bf16x8*)(VT + (dv0 + fr) * 72 + ks * 32 + fq * 8);
                for (int mt = 0; mt < (L >> 4); ++mt) {
                    f32x4 acc = (f32x4){0.f, 0.f, 0.f, 0.f};
#pragma unroll
                    for (int ks = 0; ks < 2; ++ks) {
                        const bf16x8 a = *(const bf16x8*)(SC + (mt * 16 + fr) * 72 + ks * 32 + fq * 8);
                        acc = __builtin_amdgcn_mfma_f32_16x16x32_bf16(bv[ks], a, acc, 0, 0, 0);
                    }
                    *(u32x2*)(OB + (size_t)(row0 + mt * 16 + fr) * D + h * 256 + dv0 + 4 * fq) = pack4(acc);
                }
            }
        }
    }
}

__device__ void phase_gla_inter(const Ctx& p, unsigned char* lds, int i, const int pass) {
    const bf16_t* PROJ = (const bf16_t*)(p.ws + WS_BIG);
    bf16_t* OB = (bf16_t*)(p.ws + WS_H);
    const float* DEC = (const float*)(p.ws + WS_DEC);
    const int tid = p.tid, wid = tid >> 6, lane = tid & 63, fr = lane & 15, fq = lane >> 4;
    constexpr int BUFB = 17408 + 18432 + 512;
    f32x4* GZ = (f32x4*)(p.ws + WS_GZ); float* GP = (float*)(p.ws + WS_GP);
    const int nitem = pass == 0 ? 240 + 64 : 256;
    for (int item = p.bid; item < nitem; item += p.nb) {
        int seq, h, half, seg = 0; bool with_o = true, to_z = false;
        if (pass == 0 && item >= 240) { const int j = item - 240; seq = 2 + (j >> 3); h = (j >> 1) & 3; half = j & 1; }
        else if (pass == 0) { seg = item % 15; const int j = item / 15; seq = j >> 3; h = (j >> 1) & 3; half = j & 1; with_o = false; to_z = true; }
        else { seg = item & 15; const int j = item >> 4; seq = j >> 3; h = (j >> 1) & 3; half = j & 1; }
        const int smp = seq >= 2, b = smp ? seq - 2 : seq, L = smp ? 32 : 64, nch = smp ? 1 : 16, ch0 = smp ? 512 + b : b * 256 + seg * 16;
        const int dv0 = half * 128 + wid * 16;
        const float* s_init = smp ? PAR(5) + ((size_t)(i * 8 + b) * 4 + h) * 32768 : nullptr;
        float* s_out = p.out + (smp ? O_SGLA + ((size_t)(i * 8 + b) * 4 + h) * 32768 : O_PGLA + ((size_t)(i * 2 + b) * 4 + h) * 32768);
        f32x4 S[8], Pacc[8];
#pragma unroll
        for (int kt = 0; kt < 8; ++kt) { S[kt] = (f32x4){0.f, 0.f, 0.f, 0.f}; Pacc[kt] = (f32x4){1.f, 1.f, 1.f, 1.f}; }
        if (s_init) {
#pragma unroll
            for (int kt = 0; kt < 8; ++kt)
#pragma unroll
                for (int j = 0; j < 4; ++j) S[kt][j] = s_init[(size_t)(kt * 16 + 4 * fq + j) * 256 + dv0 + fr];
        } else if (pass == 1) {
            for (int sj = 0; sj < seg; ++sj) {
                const f32x4* zp = GZ + ((((size_t)((seq * 4 + h) * 2 + half) * 15 + sj) * 8 + wid) * 8) * 64 + lane;
                const float* pp = GP + ((size_t)(seq * 4 + h) * 15 + sj) * 128 + 4 * fq;
#pragma unroll
                for (int kt = 0; kt < 8; ++kt) S[kt] = S[kt] * *(const f32x4*)(pp + kt * 16) + zp[kt * 64];
            }
        }
        __syncthreads();
#define GLA_BAR() __syncthreads()
        u32x4 gq[2][2], gk[2][2]; f32x4 gd[2]; bf16x8 gv[2]; u32x2 go[4];
        const int r_ = tid >> 3, part_ = tid & 7;
#define GLA_LOAD_QK(c, SET) do { int row0_, LL_; chunk_info(ch0 + (c), row0_, LL_); \
            if (r_ < L) { const bf16_t* q_ = PROJ + (size_t)(row0_ + r_) * NIN + h * 128 + part_ * 16; gq[SET][0] = *(const u32x4*)q_; gq[SET][1] = *(const u32x4*)(q_ + 8); \
                          const bf16_t* k_ = q_ + 512; gk[SET][0] = *(const u32x4*)k_; gk[SET][1] = *(const u32x4*)(k_ + 8); } \
            if (tid < 32) gd[SET] = *(const f32x4*)(DEC + ((size_t)(ch0 + (c)) * 4 + h) * 128 + tid * 4); } while (0)
#define GLA_STORE_LDS(buf, SET) do { unsigned char* base_ = lds + (buf) * BUFB; bf16_t* QD_ = (bf16_t*)base_; bf16_t* KT_ = (bf16_t*)(base_ + 17408); float* DC_ = (float*)(base_ + 17408 + 18432); \
            if (r_ < L) { *(u32x4*)(QD_ + r_ * 136 + part_ * 16) = gq[SET][0]; *(u32x4*)(QD_ + r_ * 136 + part_ * 16 + 8) = gq[SET][1]; \
                          const int e_ = r_ * 128 + part_ * 16, d_ = e_ / L, tk_ = e_ % L; *(u32x4*)(KT_ + d_ * 72 + tk_) = gk[SET][0]; *(u32x4*)(KT_ + d_ * 72 + tk_ + 8) = gk[SET][1]; } \
            if (tid < 32) *(f32x4*)(DC_ + tid * 4) = gd[SET]; } while (0)
        auto load_vo = [&](int c) {
            int row0, LL; chunk_info(ch0 + c, row0, LL);
#pragma unroll
            for (int ks = 0; ks < 2; ++ks) if (ks * 32 < L) {
                const int e = (dv0 + fr) * L + ks * 32 + 8 * fq;
                gv[ks] = *(const bf16x8*)(PROJ + (size_t)(row0 + (e >> 8)) * NIN + 1024 + h * 256 + (e & 255));
            }
#pragma unroll
            for (int mt = 0; mt < 4; ++mt) if (mt * 16 < L && with_o) go[mt] = *(const u32x2*)(OB + (size_t)(row0 + mt * 16 + fr) * D + h * 256 + dv0 + 4 * fq);
        };
        auto compute = [&](int c, const bf16x8 (&cv)[2], const u32x2 (&co)[4]) {
            int row0, LL; chunk_info(ch0 + c, row0, LL);
            unsigned char* base = lds + (c & 1) * BUFB;
            const bf16_t* QD = (const bf16_t*)base; const bf16_t* KT = (const bf16_t*)(base + 17408); const float* DC = (const float*)(base + 17408 + 18432);
            bf16x8 sb[4];
#pragma unroll
            for (int ks = 0; ks < 4; ++ks) {
                const u32x2 lo = pack4(S[2 * ks]), hi = pack4(S[2 * ks + 1]);
                u32x4 w = (u32x4){lo.x, lo.y, hi.x, hi.y};
                sb[ks] = *(bf16x8*)&w;
            }
            if (with_o) {
#pragma unroll
            for (int mt = 0; mt < 4; ++mt) if (mt * 16 < L) {
                f32x4 acc = (f32x4){0.f, 0.f, 0.f, 0.f};
#pragma unroll
                for (int ks = 0; ks < 4; ++ks) {
                    const u32x2 a0 = *(const u32x2*)(QD + (mt * 16 + fr) * 136 + ks * 32 + 4 * fq);
                    const u32x2 a1 = *(const u32x2*)(QD + (mt * 16 + fr) * 136 + ks * 32 + 16 + 4 * fq);
                    u32x4 w = (u32x4){a0.x, a0.y, a1.x, a1.y};
                    acc = __builtin_amdgcn_mfma_f32_16x16x32_bf16(sb[ks], *(bf16x8*)&w, acc, 0, 0, 0);
                }
                const f32x4 o = acc + unpack4(co[mt]);
                *(u32x2*)(OB + (size_t)(row0 + mt * 16 + fr) * D + h * 256 + dv0 + 4 * fq) = pack4(o);
            }
            }
#pragma unroll
            for (int kt = 0; kt < 8; ++kt) {
                const f32x4 dc = *(const f32x4*)(DC + kt * 16 + 4 * fq);
                S[kt] *= dc; Pacc[kt] *= dc;
#pragma unroll
                for (int ks = 0; ks < 2; ++ks) if (ks * 32 < L) {
                    const bf16x8 kb = *(const bf16x8*)(KT + (kt * 16 + fr) * 72 + ks * 32 + 8 * fq);
                    S[kt] = __builtin_amdgcn_mfma_f32_16x16x32_bf16(kb, cv[ks], S[kt], 0, 0, 0);
                }
            }
        };
        GLA_LOAD_QK(0, 0); load_vo(0);
        if (nch > 1) GLA_LOAD_QK(1, 1);
        GLA_STORE_LDS(0, 0);
        GLA_BAR();
        for (int c = 0; c < nch; c += 2) {
            {
                bf16x8 cv[2] = {gv[0], gv[1]}; u32x2 co[4] = {go[0], go[1], go[2], go[3]};
                if (c + 1 < nch) load_vo(c + 1);
                if (c + 2 < nch) GLA_LOAD_QK(c + 2, 0);
                compute(c, cv, co);
                if (c + 1 < nch) GLA_STORE_LDS(1, 1);
                GLA_BAR();
            }
            if (c + 1 < nch) {
                bf16x8 cv[2] = {gv[0], gv[1]}; u32x2 co[4] = {go[0], go[1], go[2], go[3]};
                if (c + 2 < nch) load_vo(c + 2);
                if (c + 3 < nch) GLA_LOAD_QK(c + 3, 1);
                compute(c + 1, cv, co);
                if (c + 2 < nch) GLA_STORE_LDS(0, 0);
                GLA_BAR();
            }
        }
        __syncthreads();
#undef GLA_LOAD_QK
#undef GLA_STORE_LDS
#undef GLA_BAR
        if (to_z) {
            f32x4* zp = GZ + ((((size_t)((seq * 4 + h) * 2 + half) * 15 + seg) * 8 + wid) * 8) * 64 + lane;
#pragma unroll
            for (int kt = 0; kt < 8; ++kt) zp[kt * 64] = S[kt];
            if (half == 0 && wid == 0 && fr == 0) {
                float* pp = GP + ((size_t)(seq * 4 + h) * 15 + seg) * 128 + 4 * fq;
#pragma unroll
                for (int kt = 0; kt < 8; ++kt) *(f32x4*)(pp + kt * 16) = Pacc[kt];
            }
        } else if (smp || seg == 15) {
#pragma unroll
            for (int kt = 0; kt < 8; ++kt)
#pragma unroll
                for (int j = 0; j < 4; ++j) s_out[(size_t)(kt * 16 + 4 * fq + j) * 256 + dv0 + fr] = S[kt][j];
        }
    }
}

__device__ void phase_gla_post(const Ctx& p, int i) {
    const bf16_t* PROJ = (const bf16_t*)(p.ws + WS_BIG);
    bf16_t* YC = (bf16_t*)(p.ws + WS_H);
    const float* gn = PAR(29) + i * 256;
    const int lane = p.tid & 63, wv = (p.bid * 512 + p.tid) >> 6, nw = (p.nb * 512) >> 6;
    const f32x4 gnv = *(const f32x4*)(gn + lane * 4);
    constexpr int NB = 4;
    for (int g0 = wv; g0 < MT * 4; g0 += nw * NB) {
        u32x2 ov[NB], gv[NB]; int rw[NB], cc[NB]; bool ok[NB];
#pragma unroll
        for (int k = 0; k < NB; ++k) {
            const int g = g0 + k * nw; ok[k] = g < MT * 4; const int gc = ok[k] ? g : g0;
            rw[k] = gc >> 2; cc[k] = (gc & 3) * 256 + lane * 4;
            ov[k] = *(const u32x2*)(YC + (size_t)rw[k] * D + cc[k]); gv[k] = *(const u32x2*)(PROJ + (size_t)rw[k] * NIN + 2048 + cc[k]);
        }
        float ss[NB];
#pragma unroll
        for (int k = 0; k < NB; ++k) { const f32x4 o = unpack4(ov[k]); ss[k] = o[0] * o[0] + o[1] * o[1] + o[2] * o[2] + o[3] * o[3]; }
#pragma unroll
        for (int of = 32; of > 0; of >>= 1) {
#pragma unroll
            for (int k = 0; k < NB; ++k) ss[k] += __shfl_xor(ss[k], of);
        }
#pragma unroll
        for (int k = 0; k < NB; ++k) {
            const float rs = rsqrtf(ss[k] * (1.0f / 256.0f) + 1e-6f);
            const f32x4 o = unpack4(ov[k]), gg = unpack4(gv[k]);
            f32x4 r;
#pragma unroll
            for (int j = 0; j < 4; ++j) r[j] = o[j] * rs * gnv[j] * gg[j] * sigmoidf_(gg[j]);
            if (ok[k]) *(u32x2*)(YC + (size_t)rw[k] * D + cc[k]) = pack4(r);
        }
    }
}

__global__ void __launch_bounds__(512, 2) fwd_megakernel(Params prm) {
    extern __shared__ __attribute__((aligned(16))) unsigned char shm[];
    cg::grid_group grid = cg::this_grid();
    int ph0 = prm.ph_lo;
    const int ph_hi = prm.ph_hi;
    if (threadIdx.x == 0) { *(volatile LAS unsigned*)((LAS unsigned char*)shm + 131072) = 0u; *(volatile LAS unsigned*)((LAS unsigned char*)shm + 131072 + 4) = 0u; }
    __syncthreads();
    const XcdBarrier xb = xcd_barrier_post((unsigned*)(prm.ws + WS_BAR), (volatile LAS unsigned*)((LAS unsigned char*)shm + 131072));
    if (ph0 == 0) {
        if (PHON(0)) phase_init(prm, shm);
        if (ph_hi > 1) grid.sync();
        ph0 = 1;
    }
    for (int ph = ph0; ph < ph_hi; ++ph) {
        Ctx p; size_t zoff = 0; p.tid = threadIdx.x; p.bid = blockIdx.x; p.nb = gridDim.x;
        asm volatile("" : "+s"(zoff), "+v"(p.tid), "+s"(p.bid), "+s"(p.nb));
        p.ws = prm.ws + zoff; p.out = (float*)((unsigned char*)prm.out + zoff);
        float* X = p.out;
        bf16_t* H = (bf16_t*)(p.ws + WS_H);
        bf16_t* BIG = (bf16_t*)(p.ws + WS_BIG);
        if (ph == NPH - 1) { if (PHON(11)) phase_final_norm(p, X, PAR(30)); }
        else {
            const int L = (ph - 1) / 13, st = (ph - 1) % 13, i = L >> 1, even = (L & 1) == 0;
            if (even && st == 8) continue;
            const int sub = st >= 10 ? 1 : 0;
            switch (st) {
            case 0: case 3: phase_rstd(p); break;
            case 10: if (PHON(1)) phase_norm(p, X, PAR(6) + (size_t)(L * 2 + 1) * D, H); break;
            case 1: case 11: if (PHON(2)) {
                pg8::Gemm g{H, w_gu(p.ws, L, sub), MT, 5632, 1024}; pg8::StaticOrder S; S.init(MT, 5632, p.nb, p.bid);
                pg8::EpiSwiGLU E{BIG, st == 1 ? (const float*)(p.ws + WS_RSTD) : nullptr};
                pg8::gemm_phase((LAS unsigned char*)shm, g, S, E, p.tid);
            } break;
            case 2: case 12: case 9: if (PHON(3)) {
                pg8::Gemm g; pg8::EpiResid E;
                const bool emit = st == 2 || (st == 12 && L < 3);
                bf16_t* xb = emit ? H : nullptr; float* ssp = (float*)(p.ws + WS_SSP);
                if (st == 9) { g = pg8::Gemm{H, w_out(p.ws, L), MP, 1024, 1024}; E = pg8::EpiResid{X, 1.0f, nullptr, ssp}; }
                else { g = pg8::Gemm{BIG, w_dn(p.ws, L, sub), MP, 1024, DFF}; E = pg8::EpiResid{X, 0.5f, xb, ssp}; }
                pg8::StaticOrder S; S.init(MP, 1024, p.nb, p.bid);
                pg8::gemm_phase((LAS unsigned char*)shm, g, S, E, p.tid);
                sample_gemm_splitk(p, shm, g.A, g.Bt, g.K, X, E.scale, E.XB, ssp);
            } break;
            case 4: if (PHON(4)) {
                pg8::Gemm g{H, w_in(p.ws, L), MT, NIN, 1024}; pg8::StaticOrder S; S.init(MT, NIN, p.nb, p.bid);
                pg8::EpiProj E{BIG, (bf16_t*)(p.ws + WS_HALO), (const float*)(p.ws + WS_RSTD)};
                pg8::gemm_phase((LAS unsigned char*)shm, g, S, E, p.tid);
            } break;
            case 5: if (even) { if (PHON(5)) phase_even_prep(p, shm, i); } else { if (PHON(8)) phase_gla_intra(p, shm, i); } break;
            case 6: case 7: if (even) { if (st == 6) { if (PHON(6)) phase_scan(p, shm, i); } else { if (PHON(7)) phase_even_post(p, i); } } else { if (PHON(9)) phase_gla_inter(p, shm, i, st - 6); } break;
            case 8: if (PHON(10)) phase_gla_post(p, i); break;
            default: break;
            }
        }
        if (ph + 1 < ph_hi) xcd_barrier(xb);
    }
}

extern "C" void kernel_launch(void* const* d_in, const int* in_sizes, int n_in, void* d_out, int out_size, void* d_ws, size_t ws_size, hipStream_t stream) {
    static int grid = 0;
    if (grid == 0) {
        bool bad = n_in != 31 || (size_t)out_size != O_END || ws_size < WS_END || in_sizes[0] != MP * D || in_sizes[1] != MS * D;
        for (int k = 0; k < NPAR && !bad; ++k) if ((size_t)in_sizes[PIDX[k]] != PSZ[k]) bad = true;
        if (bad) { fprintf(stderr, "kernel_launch: unexpected shapes\n"); grid = -1; return; }
        int dev = 0, cus = 0, per_cu = 0;
        hipGetDevice(&dev);
        hipDeviceGetAttribute(&cus, hipDeviceAttributeMultiprocessorCount, dev);
        if (hipFuncSetAttribute((const void*)fwd_megakernel, hipFuncAttributeMaxDynamicSharedMemorySize, LDS_BYTES) != hipSuccess) { fprintf(stderr, "kernel_launch: hipFuncSetAttribute failed\n"); grid = -1; return; }
        if (hipOccupancyMaxActiveBlocksPerMultiprocessor(&per_cu, (const void*)fwd_megakernel, 512, LDS_BYTES) != hipSuccess || per_cu < 1) { fprintf(stderr, "kernel_launch: occupancy query gave %d\n", per_cu); per_cu = 1; }
        (void)hipGetLastError();
        grid = cus * 1;
        if (grid > 256) grid = 256;
    }
    if (grid < 0) return;
    Params p{};
    for (int i = 0; i < 31; ++i) p.in[i] = (const float*)d_in[i];
    p.out = (float*)d_out; p.ws = (unsigned char*)d_ws;
    if (hipMemsetAsync((unsigned char*)d_ws + WS_BAR, 0, 16384, stream) != hipSuccess) { fprintf(stderr, "kernel_launch: memset of the barrier words failed\n"); return; }
    p.ph_lo = 0; p.ph_hi = NPH;
    void* args[] = {&p};
    hipError_t e = hipLaunchCooperativeKernel((const void*)fwd_megakernel, dim3(grid), dim3(512), args, LDS_BYTES, stream);
    if (e != hipSuccess) fprintf(stderr, "cooperative launch failed: %s (grid %d)\n", hipGetErrorString(e), grid);
}
```
